# Optimizing an MI355X kernel written in HIP

```python
import math
import jax
import jax.numpy as jnp
from jax import lax
import numpy as np

D_MODEL = 1024
BATCH = 32
SEQ = 2048
DEPTH = 1

HEAD_DIM = 64
NA_HEADS = 8
NA_WIDTH = NA_HEADS * HEAD_DIM
DIFF_HEADS = 4
DIFF_QK_WIDTH = DIFF_HEADS * 2 * HEAD_DIM
DIFF_V_DIM = 2 * HEAD_DIM
DIFF_WIDTH = DIFF_HEADS * DIFF_V_DIM
IN_COLS = 3 * NA_WIDTH + 2 * DIFF_QK_WIDTH + DIFF_WIDTH
N_BRANCH = 2
GRID_W = 64
WIN_ROWS = 8
WIN_COLS = 16
Q_BLOCK = 128
D_FF = 2816
CONV_W = 3
N_MOD = 6
EPS = 1e-6

kernel_name = "hybrid_natten_diffattn_convffn_block"


def rms_norm(x, gain):
    xf = x.astype(jnp.float32)
    y = xf * lax.rsqrt(jnp.mean(xf * xf, axis=-1, keepdims=True) + EPS)
    return (y * gain.astype(jnp.float32)).astype(x.dtype)


def alibi_slopes(n_heads):
    return jnp.asarray([2.0 ** (-8.0 * (h + 1) / n_heads) for h in range(n_heads)], dtype=jnp.float32)


def lambda_init_for(layer_idx):
    return 0.8 - 0.6 * math.exp(-0.3 * layer_idx)


def neighborhood_attention(q, k, v, rpb):
    b, s, h, dh = q.shape
    rows = s // GRID_W
    kr = min(WIN_ROWS, rows)
    kc = WIN_COLS
    qg = q.reshape(b, rows, GRID_W, h, dh)
    kg = k.reshape(b, rows, GRID_W, h, dh)
    vg = v.reshape(b, rows, GRID_W, h, dh)
    col = jnp.arange(GRID_W)
    col_idx = jnp.clip(col - kc // 2, 0, GRID_W - kc)[:, None] + jnp.arange(kc)[None, :]
    dc = col_idx - col[:, None] + (WIN_COLS - 1)
    r_idx = jnp.arange(rows)
    row_start = jnp.clip(r_idx - kr // 2, 0, rows - kr)
    scale = dh ** -0.5

    def one_row(args):
        q_row, r, r0 = args
        k_band = lax.dynamic_slice_in_dim(kg, r0, kr, axis=1)
        v_band = lax.dynamic_slice_in_dim(vg, r0, kr, axis=1)
        k_nb = k_band[:, :, col_idx]
        v_nb = v_band[:, :, col_idx]
        logits = jnp.einsum('bchd,brckhd->bhcrk', q_row, k_nb,
                            preferred_element_type=jnp.float32) * scale
        dr = r0 + jnp.arange(kr) - r + (WIN_ROWS - 1)
        bias = rpb[:, dr[None, :, None], dc[:, None, :]]
        logits = logits + bias.astype(jnp.float32)[None]
        p = jax.nn.softmax(logits.reshape(b, h, GRID_W, kr * kc), axis=-1)
        p = p.reshape(b, h, GRID_W, kr, kc).astype(v.dtype)
        return jnp.einsum('bhcrk,brckhd->bchd', p, v_nb)

    out = lax.map(one_row, (jnp.moveaxis(qg, 1, 0), r_idx, row_start))
    return jnp.moveaxis(out, 0, 1).reshape(b, s, h * dh)


def differential_attention(q, k, v, lam, lambda_init, subln_gain):
    b, s, h, _, dh = q.shape
    nb = s // Q_BLOCK
    slopes = alibi_slopes(h)
    pos = jnp.arange(s, dtype=jnp.float32)
    scale = dh ** -0.5
    qb = jnp.moveaxis(q.reshape(b, nb, Q_BLOCK, h, 2, dh), 1, 0)
    qpos = pos.reshape(nb, Q_BLOCK)

    def one_block(args):
        q_blk, tq = args
        logits = jnp.einsum('bqhcd,bkhcd->bhcqk', q_blk, k,
                            preferred_element_type=jnp.float32) * scale
        bias = -slopes[:, None, None] * jnp.abs(tq[:, None] - pos[None, :])
        p = jax.nn.softmax(logits + bias[None, :, None], axis=-1)
        a = p[:, :, 0] - lam * p[:, :, 1]
        return jnp.einsum('bhqk,bkhd->bqhd', a.astype(v.dtype), v)

    out = lax.map(one_block, (qb, qpos))
    out = jnp.moveaxis(out, 0, 1).reshape(b, s, h, -1)
    out = rms_norm(out, subln_gain) * (1.0 - lambda_init)
    return out.reshape(b, s, -1)


def depthwise_conv_centered(u, w, bias):
    pad = CONV_W // 2
    s = u.shape[1]
    up = jnp.pad(u, ((0, 0), (pad, pad), (0, 0)))
    out = up[:, 0:s] * w[0]
    for i in range(1, CONV_W):
        out = out + up[:, i:i + s] * w[i]
    return out + bias


def setup_inputs(seed: int = 0) -> dict:
    key = jax.random.key(seed)
    ks = jax.random.split(key, 32)
    D = D_MODEL
    nrm = lambda k, shape, s: jax.random.normal(k, shape, dtype=jnp.float32) * s
    gain = lambda k, shape: 1.0 + nrm(k, shape, 0.02)
    return {
        "x": nrm(ks[0], (BATCH, SEQ, D), 1.0),
        "c": nrm(ks[1], (BATCH, D), 1.0),
        "ada_w": nrm(ks[2], (DEPTH, D, N_MOD * D), 0.5 * D ** -0.5),
        "ada_b": nrm(ks[3], (DEPTH, N_MOD * D), 0.02),
        "norm1_g": gain(ks[4], (DEPTH, D)),
        "w_in": nrm(ks[5], (DEPTH, D, IN_COLS), D ** -0.5),
        "na_q_g": gain(ks[6], (DEPTH, HEAD_DIM)),
        "na_k_g": gain(ks[7], (DEPTH, HEAD_DIM)),
        "na_rpb": nrm(ks[8], (DEPTH, NA_HEADS, 2 * WIN_ROWS - 1, 2 * WIN_COLS - 1), 0.1),
        "df_q_g": gain(ks[9], (DEPTH, HEAD_DIM)),
        "df_k_g": gain(ks[10], (DEPTH, HEAD_DIM)),
        "lam_q1": nrm(ks[11], (DEPTH, HEAD_DIM), 0.1),
        "lam_k1": nrm(ks[12], (DEPTH, HEAD_DIM), 0.1),
        "lam_q2": nrm(ks[13], (DEPTH, HEAD_DIM), 0.1),
        "lam_k2": nrm(ks[14], (DEPTH, HEAD_DIM), 0.1),
        "df_subln_g": gain(ks[15], (DEPTH, DIFF_V_DIM)),
        "w_na_proj": nrm(ks[16], (DEPTH, NA_WIDTH, D), NA_WIDTH ** -0.5),
        "w_df_proj": nrm(ks[17], (DEPTH, DIFF_WIDTH, D), DIFF_WIDTH ** -0.5),
        "w_gate": nrm(ks[18], (DEPTH, D, N_BRANCH * D), D ** -0.5),
        "b_gate": nrm(ks[19], (DEPTH, N_BRANCH * D), 0.02),
        "w_out": nrm(ks[20], (DEPTH, D, D), D ** -0.5),
        "norm2_g": gain(ks[21], (DEPTH, D)),
        "w_up": nrm(ks[22], (DEPTH, D, 2 * D_FF), D ** -0.5),
        "conv_w": nrm(ks[23], (DEPTH, CONV_W, 2 * D_FF), CONV_W ** -0.5),
        "conv_b": nrm(ks[24], (DEPTH, 2 * D_FF), 0.01),
        "w_down": nrm(ks[25], (DEPTH, D_FF, D), D_FF ** -0.5),
    }


def reference(x, c, ada_w, ada_b, norm1_g, w_in, na_q_g, na_k_g, na_rpb, df_q_g, df_k_g,
              lam_q1, lam_k1, lam_q2, lam_k2, df_subln_g, w_na_proj, w_df_proj, w_gate, b_gate,
              w_out, norm2_g, w_up, conv_w, conv_b, w_down):
    b, s, _ = x.shape
    splits = [NA_WIDTH, 2 * NA_WIDTH, 3 * NA_WIDTH, 3 * NA_WIDTH + DIFF_QK_WIDTH,
              3 * NA_WIDTH + 2 * DIFF_QK_WIDTH]
    c_act = jax.nn.silu(c)
    for l in range(DEPTH):
        lam_init = lambda_init_for(l)
        mod = (jnp.einsum('bd,de->be', c_act, ada_w[l]) + ada_b[l])[:, None, :]
        sh1, sc1, g1, sh2, sc2, g2 = jnp.split(mod, N_MOD, axis=-1)

        h = rms_norm(x, norm1_g[l]) * (1.0 + sc1) + sh1
        proj = jnp.einsum('bsd,de->bse', h, w_in[l])
        na_q, na_k, na_v, df_q, df_k, df_v = jnp.split(proj, splits, axis=-1)

        na_q = rms_norm(na_q.reshape(b, s, NA_HEADS, HEAD_DIM), na_q_g[l])
        na_k = rms_norm(na_k.reshape(b, s, NA_HEADS, HEAD_DIM), na_k_g[l])
        na_v = na_v.reshape(b, s, NA_HEADS, HEAD_DIM)
        y_na = neighborhood_attention(na_q, na_k, na_v, na_rpb[l])

        df_q = rms_norm(df_q.reshape(b, s, DIFF_HEADS, 2, HEAD_DIM), df_q_g[l])
        df_k = rms_norm(df_k.reshape(b, s, DIFF_HEADS, 2, HEAD_DIM), df_k_g[l])
        df_v = df_v.reshape(b, s, DIFF_HEADS, DIFF_V_DIM)
        lam = (jnp.exp(jnp.sum(lam_q1[l].astype(jnp.float32) * lam_k1[l].astype(jnp.float32)))
               - jnp.exp(jnp.sum(lam_q2[l].astype(jnp.float32) * lam_k2[l].astype(jnp.float32)))
               + lam_init)
        y_df = differential_attention(df_q, df_k, df_v, lam, lam_init, df_subln_g[l])

        ya = jnp.einsum('bse,ed->bsd', y_na, w_na_proj[l])
        yb = jnp.einsum('bse,ed->bsd', y_df, w_df_proj[l])
        gates = jax.nn.sigmoid(jnp.einsum('bsd,de->bse', h, w_gate[l]) + b_gate[l])
        ga, gb = jnp.split(gates, N_BRANCH, axis=-1)
        mixed = jnp.einsum('bsd,de->bse', ga * ya + gb * yb, w_out[l])
        x = x + g1 * mixed

        h2 = rms_norm(x, norm2_g[l]) * (1.0 + sc2) + sh2
        u = jnp.einsum('bsd,df->bsf', h2, w_up[l])
        u = depthwise_conv_centered(u, conv_w[l], conv_b[l])
        u_act, u_lin = jnp.split(u, 2, axis=-1)
        f = jnp.einsum('bsf,fd->bsd', jax.nn.gelu(u_act, approximate=False) * u_lin, w_down[l])
        x = x + g2 * f
    return x
```

```cpp
#include <hip/hip_runtime.h>
#include <hip/hip_cooperative_groups.h>
#include <cstdio>
#include <cstdint>
namespace cg = cooperative_groups;
#ifndef PH_MASK
#define PH_MASK 0xff
#endif
#ifndef DUP_MASK
#define DUP_MASK 0
#endif

#define LAS __attribute__((address_space(3)))
typedef unsigned short bf16_t;
typedef short bf16x8 __attribute__((ext_vector_type(8)));
typedef float f32x4 __attribute__((ext_vector_type(4)));
typedef float f32x16 __attribute__((ext_vector_type(16)));
typedef float f32x2 __attribute__((ext_vector_type(2)));
typedef unsigned u32x4 __attribute__((ext_vector_type(4)));
typedef unsigned u32x2 __attribute__((ext_vector_type(2)));
typedef __bf16 bf16x2_t __attribute__((ext_vector_type(2)));

constexpr int M_TOK = 65536, DM = 1024, SEQ = 2048, NBATCH = 32, DFF = 2816, NUP = 5632, NMOD = 6144;
constexpr float EPS = 1e-6f, LOG2E = 1.4426950408889634f, QSCALE = 0.125f * 1.4426950408889634f;
constexpr int NWAVES = 8;
constexpr int LDS_BYTES = 131072 + 1024;

constexpr size_t MiB = 1u << 20;
constexpr size_t WS_MOD = 0;
constexpr size_t WS_BAR = 900 * 1024;
constexpr size_t WS_W1A = 1 * MiB;
constexpr size_t WS_WV = 9 * MiB;
constexpr size_t WS_WBR = 11 * MiB;
constexpr size_t WS_WOUT = 13 * MiB;
constexpr size_t WS_WUP = 15 * MiB;
constexpr size_t WS_WDN = 26 * MiB;
constexpr size_t WS_H = 32 * MiB + 4096;
constexpr size_t WS_QK = 161 * MiB;
constexpr size_t WS_GATES = 417 * MiB;
constexpr size_t WS_VT = 673 * MiB;
constexpr size_t WS_Y = 801 * MiB;
constexpr size_t WS_MIX = 161 * MiB;
constexpr size_t WS_ACT = 289 * MiB;
constexpr size_t WS_PARK = 929 * MiB;
constexpr size_t WS_H8 = 801 * MiB;
constexpr size_t WS_WG8 = 961 * MiB;
constexpr size_t WS_END = 963 * MiB;

struct Args {
    const float *x, *c, *ada_w, *ada_b, *norm1_g, *w_in, *na_q_g, *na_k_g, *na_rpb, *df_q_g, *df_k_g, *lam_q1, *lam_k1, *lam_q2, *lam_k2, *df_subln_g,
        *w_na_proj, *w_df_proj, *w_gate, *b_gate, *w_out, *norm2_g, *w_up, *conv_w, *conv_b, *w_down;
    float* out; unsigned char* ws;
};

__device__ __forceinline__ unsigned pk2(float lo, float hi) { f32x2 v = {lo, hi}; bf16x2_t b = __builtin_convertvector(v, bf16x2_t); return __builtin_bit_cast(unsigned, b); }
__device__ __forceinline__ float bf_lo(unsigned u) { return __uint_as_float(u << 16); }
__device__ __forceinline__ float bf_hi(unsigned u) { return __uint_as_float(u & 0xffff0000u); }
__device__ __forceinline__ float wave_sum(float v) {
#pragma unroll
    for (int o = 1; o < 64; o <<= 1) v += __shfl_xor(v, o);
    return v;
}
__device__ __forceinline__ f32x2 gelu_pk(f32x2 v) {
    const f32x2 av = __builtin_elementwise_abs(v), d = av * 0.2316418882f + 1.0f;
    f32x2 t; t.x = __builtin_amdgcn_rcpf(d.x); t.y = __builtin_amdgcn_rcpf(d.y);
    f32x2 q = t * 0.5307027145f + (-0.7265760135f); q = q * t + 0.7107068705f; q = q * t + (-0.142248368f); q = q * t + 0.127414796f; q = q * t;
    const f32x2 s = (v * v) * (-0.72134752044f);
    f32x2 e; e.x = __builtin_amdgcn_exp2f(s.x); e.y = __builtin_amdgcn_exp2f(s.y);
    const f32x2 m = v * (q * e), r = v - m;
    f32x2 o; o.x = v.x < 0.f ? m.x : r.x; o.y = v.y < 0.f ? m.y : r.y; return o;
}
__device__ __forceinline__ float dpp_rr1(float v) { return __int_as_float(__builtin_amdgcn_update_dpp(0, __float_as_int(v), 0x121, 0xF, 0xF, false)); }
__device__ __forceinline__ float dpp_rr15(float v) { return __int_as_float(__builtin_amdgcn_update_dpp(0, __float_as_int(v), 0x12F, 0xF, 0xF, false)); }
__device__ __forceinline__ float dpp_shr1(float old, float v) { return __int_as_float(__builtin_amdgcn_update_dpp(__float_as_int(old), __float_as_int(v), 0x111, 0xF, 0xF, false)); }
__device__ __forceinline__ float dpp_shl1(float old, float v) { return __int_as_float(__builtin_amdgcn_update_dpp(__float_as_int(old), __float_as_int(v), 0x101, 0xF, 0xF, false)); }
__device__ __forceinline__ float bperm(float v, int byteaddr) { return __int_as_float(__builtin_amdgcn_ds_bpermute(byteaddr, __float_as_int(v))); }
__device__ __forceinline__ float sigmoidf_(float x) { return __builtin_amdgcn_rcpf(1.0f + __builtin_amdgcn_exp2f(-x * LOG2E)); }

namespace pg8 {
constexpr int BM = 256, BK = 64, HALF = 128, HTB = HALF * BK * 2, STAGE_BYTES = 8 * HTB, NXCD = 8, WGM = 8;
__device__ __forceinline__ int lds_byte(int r, int c) { const int st = (r >> 4) * 2 + (c >> 5), rr = r & 15, cc = c & 31, ob = rr * 64 + cc * 2; return st * 1024 + (ob ^ (((ob >> 9) & 1) << 5)); }
__device__ __forceinline__ void stage_rc(int b, int& R, int& C) { const int st = b / 1024, sb = b % 1024, swz = sb ^ (((sb >> 9) & 1) << 5); R = (st >> 1) * 16 + swz / 64; C = (st & 1) * 32 + (swz % 64) / 2; }
__device__ __forceinline__ int perm32(int rho) { const int n = rho >> 4, i = rho & 15; return 8 * (i >> 2) + 4 * n + (i & 3); }

typedef int v8i_t __attribute__((ext_vector_type(8)));
typedef int v4i_t __attribute__((ext_vector_type(4)));
__device__ __forceinline__ v8i_t cat8(bf16x8 lo, bf16x8 hi) { const v4i_t a = __builtin_bit_cast(v4i_t, lo), b = __builtin_bit_cast(v4i_t, hi); return __builtin_shufflevector(a, b, 0, 1, 2, 3, 4, 5, 6, 7); }

struct Unit { int pm, pn, br; };

struct Sched {
    int nM, nN, nwg, G, c, pairs;
    const char* A; const char* B; unsigned a_tile, b_tile, a_br, b_br;
    __device__ __forceinline__ bool next(int i, Unit& u) const {
        int ii = i; u.br = 0; if (pairs == 0) { if (i >= nN || c >= nM) return false; u.pm = c; u.pn = i; return true; }
        if (pairs == 2) { ii = i >> 1; u.br = i & 1; }
        const long L = (long)ii * G + c; if (L >= nwg) return false;
        int wgid = (int)L; { const int q = nwg / NXCD, r = nwg % NXCD, xcd = wgid % NXCD, off = wgid / NXCD; wgid = (xcd < r ? xcd * (q + 1) : r * (q + 1) + (xcd - r) * q) + off; }
        const int nig = WGM * nN, gid = wgid / nig, fm = gid * WGM, gsz = (nM - fm) < WGM ? (nM - fm) : WGM;
        u.pm = fm + ((wgid % nig) % gsz); u.pn = (wgid % nig) / gsz; return true;
    }
    __device__ __forceinline__ const char* a_ptr(const Unit& u) const { return A + (size_t)u.pm * a_tile + (size_t)u.br * a_br; }
    __device__ __forceinline__ const char* b_ptr(const Unit& u) const { return B + (size_t)u.pn * b_tile + (size_t)u.br * b_br; }
};

struct Sched2 {
    int nM0, nN0, nwg0, nM1, nN1, nwg1, G, c;
    const char *A0, *B0, *A1, *B1; unsigned a_tile, b_tile;
    static __device__ __forceinline__ void map(int L, int nM, int nN, int nwg, Unit& u) {
        int wgid = L; { const int q = nwg / NXCD, r = nwg % NXCD, xcd = wgid % NXCD, off = wgid / NXCD; wgid = (xcd < r ? xcd * (q + 1) : r * (q + 1) + (xcd - r) * q) + off; }
        const int nig = WGM * nN, gid = wgid / nig, fm = gid * WGM, gsz = (nM - fm) < WGM ? (nM - fm) : WGM;
        u.pm = fm + ((wgid % nig) % gsz); u.pn = (wgid % nig) / gsz;
    }
    __device__ __forceinline__ bool next(int i, Unit& u) const {
        const long L = (long)i * G + c;
        if (L < nwg0) { u.br = 0; map((int)L, nM0, nN0, nwg0, u); return true; }
        if (L - nwg0 < nwg1) { u.br = 1; map((int)(L - nwg0), nM1, nN1, nwg1, u); return true; }
        return false;
    }
    __device__ __forceinline__ const char* a_ptr(const Unit& u) const { return (u.br ? A1 : A0) + (size_t)u.pm * a_tile; }
    __device__ __forceinline__ const char* b_ptr(const Unit& u) const { return (u.br ? B1 : B0) + (size_t)u.pn * b_tile; }
};

template <class Epi, bool STRIPS, bool FP8 = false, class SchedT = Sched>
__device__ __forceinline__ void gemm_phase(LAS unsigned char* lds, const int K, const int lda, const int ldb, const SchedT& S, const Epi& E) {
    int tid_ = threadIdx.x; asm volatile("" : "+v"(tid_));
    const int tid = tid_, wid = __builtin_amdgcn_readfirstlane(tid >> 6), lane = tid & 63, wr = wid >> 2, wc = wid & 3, fr = lane & 15, fq = lane >> 4;
    const int nt = K / BK;
    unsigned voffA, voffB;
    { int R, C; stage_rc(tid * 16, R, C); const int Rb = Epi::PERM ? ((R & ~31) + perm32(R & 31)) : R;
        const int Ra = R;
        voffA = (unsigned)(Ra * lda + C) * 2u; voffB = (unsigned)(Rb * ldb + C) * 2u; }
    const size_t pstep_voffA = (size_t)(STRIPS ? 62 : 64) * lda * 2, pstep_voffB = (size_t)64 * ldb * 2;
    const size_t kstep = (size_t)(BK * 2);
    const size_t hstepA = (size_t)(STRIPS ? 124 : 128) * lda * 2, hstepB = (size_t)HALF * ldb * 2;
    const unsigned ldsw = (unsigned)wid * 1024u;
    const int aoff = lds_byte(wr * 64 + fr, fq * 8), boff = lds_byte(wc * 32 + fr, fq * 8);
#define PG8_SA(b, h) (((b) * 2 + (h)) * HTB)
#define PG8_SB(b, h) ((4 + (b) * 2 + (h)) * HTB)
#define PG8_STAGE(bufoff, gbase, voff) do { _Pragma("unroll") for (int _i = 0; _i < 2; ++_i) \
        __builtin_amdgcn_global_load_lds((const unsigned*)((const char*)(gbase) + _i * pstep_##voff + (voff)), (LAS unsigned*)(lds + (bufoff) + ldsw + _i * 8192), 16, 0, 0); } while (0)
#define PG8_LDA(dst, b, h) do { _Pragma("unroll") for (int m = 0; m < 4; ++m) _Pragma("unroll") for (int k = 0; k < 2; ++k) dst[m][k] = *(const LAS bf16x8*)(lds + PG8_SA(b, h) + aoff + m * 2048 + k * 1024); } while (0)
#define PG8_LDB(dst, b, h) do { _Pragma("unroll") for (int n = 0; n < 2; ++n) _Pragma("unroll") for (int k = 0; k < 2; ++k) dst[n][k] = *(const LAS bf16x8*)(lds + PG8_SB(b, h) + boff + n * 2048 + k * 1024); } while (0)
#define PG8_MMA(ai, bj, At, Bt) do { __builtin_amdgcn_s_setprio(1); \
        if constexpr (FP8) {   \
            _Pragma("unroll") for (int m = 0; m < 4; ++m) _Pragma("unroll") for (int n = 0; n < 2; ++n) \
                acc[ai][bj][m][n] = __builtin_amdgcn_mfma_scale_f32_16x16x128_f8f6f4(cat8(Bt[n][0], Bt[n][1]), cat8(At[m][0], At[m][1]), acc[ai][bj][m][n], 0, 0, 0, 0, 0, 0);   \
        } else { \
            _Pragma("unroll") for (int m = 0; m < 4; ++m) _Pragma("unroll") for (int n = 0; n < 2; ++n) _Pragma("unroll") for (int k = 0; k < 2; ++k) \
                acc[ai][bj][m][n] = __builtin_amdgcn_mfma_f32_16x16x32_bf16(Bt[n][k], At[m][k], acc[ai][bj][m][n], 0, 0, 0); \
        } __builtin_amdgcn_s_setprio(0); } while (0)
#define PG8_WAIT_V(n) asm volatile("s_waitcnt vmcnt(" #n ")" ::: "memory")
#define PG8_WAIT_L(n) asm volatile("s_waitcnt lgkmcnt(" #n ")" ::: "memory")
#define PG8_BAR __builtin_amdgcn_s_barrier()
#define PG8_SCHED __builtin_amdgcn_sched_barrier(0)
    Unit cur, nxt; int ui = 0;
    if (!S.next(0, cur)) return;
    f32x4 acc[2][2][4][2];
#pragma unroll
    for (int a = 0; a < 2; ++a)
#pragma unroll
        for (int b = 0; b < 2; ++b)
#pragma unroll
            for (int m = 0; m < 4; ++m)
#pragma unroll
                for (int n = 0; n < 2; ++n) acc[a][b][m][n] = (f32x4){0.f, 0.f, 0.f, 0.f};
    bf16x8 At[4][2], B0[2][2], B1[2][2];
    const char* cA = S.a_ptr(cur); const char* cB = S.b_ptr(cur);
    PG8_STAGE(PG8_SB(0, 0), cB, voffB); PG8_STAGE(PG8_SB(0, 1), cB + hstepB, voffB); PG8_STAGE(PG8_SA(0, 0), cA, voffA); PG8_STAGE(PG8_SA(0, 1), cA + hstepA, voffA);
    if (wr == 1) PG8_BAR;
    PG8_WAIT_V(2); PG8_BAR;
    PG8_STAGE(PG8_SB(1, 0), cB + kstep, voffB); PG8_STAGE(PG8_SA(1, 0), cA + kstep, voffA); PG8_STAGE(PG8_SB(1, 1), cB + hstepB + kstep, voffB);
    PG8_WAIT_V(6); PG8_BAR;
    for (;;) {
        const bool has_next = S.next(ui + 1, nxt);
        const char* nA = has_next ? S.a_ptr(nxt) : cA; const char* nB = has_next ? S.b_ptr(nxt) : cB;
#pragma unroll 1
        for (int t = 0; t < nt; t += 2) {
            const bool last = (t == nt - 2);
            const char* a1 = cA + (size_t)(t + 1) * kstep;
            const char* a2 = last ? nA : cA + (size_t)(t + 2) * kstep; const char* b2 = last ? nB : cB + (size_t)(t + 2) * kstep;
            const char* a3 = a2 + kstep; const char* b3 = b2 + kstep;
            PG8_LDB(B0, 0, 0); PG8_LDB(B1, 0, 1); PG8_SCHED; PG8_LDA(At, 0, 0); PG8_STAGE(PG8_SA(1, 1), a1 + hstepA, voffA);
            PG8_WAIT_V(8); PG8_WAIT_L(0); PG8_BAR; PG8_MMA(0, 0, At, B0); PG8_MMA(0, 1, At, B1); PG8_BAR; PG8_SCHED;
            PG8_LDA(At, 0, 1); PG8_STAGE(PG8_SB(0, 0), b2, voffB); PG8_STAGE(PG8_SB(0, 1), b2 + hstepB, voffB); PG8_STAGE(PG8_SA(0, 0), a2, voffA);
            PG8_WAIT_V(8); PG8_WAIT_L(0); PG8_BAR; PG8_MMA(1, 0, At, B0); PG8_MMA(1, 1, At, B1); PG8_BAR; PG8_SCHED;
            PG8_LDB(B0, 1, 0); PG8_LDB(B1, 1, 1); PG8_SCHED; PG8_LDA(At, 1, 0); PG8_STAGE(PG8_SA(0, 1), a2 + hstepA, voffA);
            PG8_WAIT_V(8); PG8_WAIT_L(0); PG8_BAR; PG8_MMA(0, 0, At, B0); PG8_MMA(0, 1, At, B1); PG8_BAR; PG8_SCHED;
            PG8_LDA(At, 1, 1); PG8_STAGE(PG8_SB(1, 0), b3, voffB); PG8_STAGE(PG8_SB(1, 1), b3 + hstepB, voffB); PG8_STAGE(PG8_SA(1, 0), a3, voffA);
            PG8_WAIT_V(8); PG8_WAIT_L(0); PG8_BAR; PG8_MMA(1, 0, At, B0); PG8_MMA(1, 1, At, B1); PG8_BAR; PG8_SCHED;
        }
        if (wr == 0) PG8_BAR;
        { int te_ = threadIdx.x; asm volatile("" : "+v"(te_));
          E(acc, cur, wr, wc, te_ & 15, (te_ >> 4) & 3); }
        if (!has_next) break;
#pragma unroll
        for (int a = 0; a < 2; ++a)
#pragma unroll
            for (int b = 0; b < 2; ++b)
#pragma unroll
                for (int m = 0; m < 4; ++m)
#pragma unroll
                    for (int n = 0; n < 2; ++n) acc[a][b][m][n] = (f32x4){0.f, 0.f, 0.f, 0.f};
        cur = nxt; cA = nA; cB = nB; ++ui;
        if (wr == 1) PG8_BAR;
    }
    PG8_WAIT_V(0);
    PG8_BAR;
#undef PG8_SA
#undef PG8_SB
#undef PG8_STAGE
#undef PG8_LDA
#undef PG8_LDB
#undef PG8_MMA
#undef PG8_WAIT_V
#undef PG8_WAIT_L
#undef PG8_BAR
#undef PG8_SCHED
}

typedef const f32x4 (&AccRef)[2][2][4][2];

struct EpiG1a {
    static constexpr bool PERM = true;
    bf16_t* QK; bf16_t* GATES; const float* gtab; const float* b_gate;
    __device__ __forceinline__ void operator()(AccRef acc, const Unit& u, int wr, int wc, int fr, int fq) const {
        const int row0 = u.pm * BM + wr * 64 + fr;
        if (u.pn < 8) {
            const int region = u.pn >> 1; const float* g = gtab + region * 64;
            const float qs = (region == 0 || region == 2) ? QSCALE : 1.0f;
            const f32x4 gv00 = *(const f32x4*)(g + 8 * fq) * qs, gv01 = *(const f32x4*)(g + 8 * fq + 4) * qs, gv10 = *(const f32x4*)(g + 32 + 8 * fq) * qs, gv11 = *(const f32x4*)(g + 32 + 8 * fq + 4) * qs;
            const int col0 = u.pn * 256 + 64 * wc + 8 * fq;
#pragma unroll
            for (int ai = 0; ai < 2; ++ai)
#pragma unroll
                for (int m = 0; m < 4; ++m) {
                    float ss = 0.f;
#pragma unroll
                    for (int bj = 0; bj < 2; ++bj)
#pragma unroll
                        for (int n = 0; n < 2; ++n) { const f32x4 v = acc[ai][bj][m][n]; ss += (v[0] * v[0] + v[1] * v[1]) + (v[2] * v[2] + v[3] * v[3]); }
                    ss += __shfl_xor(ss, 16); ss += __shfl_xor(ss, 32);
                    const float rstd = rsqrtf(ss * (1.0f / 64.0f) + EPS);
                    bf16_t* rowp = QK + (size_t)(row0 + ai * HALF + m * 16) * 2048 + col0;
#pragma unroll
                    for (int bj = 0; bj < 2; ++bj) { const f32x4 v0 = acc[ai][bj][m][0] * rstd * (bj ? gv10 : gv00), v1 = acc[ai][bj][m][1] * rstd * (bj ? gv11 : gv01);
                        u32x4 w; w.x = pk2(v0[0], v0[1]); w.y = pk2(v0[2], v0[3]); w.z = pk2(v1[0], v1[1]); w.w = pk2(v1[2], v1[3]);
                        *(u32x4*)(rowp + 32 * bj) = w; }
                }
        } else {
            const int col0 = (u.pn - 8) * 256 + 64 * wc + 8 * fq;
            const f32x4 bv00 = *(const f32x4*)(b_gate + col0), bv01 = *(const f32x4*)(b_gate + col0 + 4), bv10 = *(const f32x4*)(b_gate + col0 + 32), bv11 = *(const f32x4*)(b_gate + col0 + 36);
#pragma unroll
            for (int ai = 0; ai < 2; ++ai)
#pragma unroll
                for (int m = 0; m < 4; ++m) { bf16_t* rowp = GATES + (size_t)(row0 + ai * HALF + m * 16) * 2048 + col0;
#pragma unroll
                    for (int bj = 0; bj < 2; ++bj) { const f32x4 v0 = acc[ai][bj][m][0] + (bj ? bv10 : bv00), v1 = acc[ai][bj][m][1] + (bj ? bv11 : bv01);
                        u32x4 w; w.x = pk2(sigmoidf_(v0[0]), sigmoidf_(v0[1])); w.y = pk2(sigmoidf_(v0[2]), sigmoidf_(v0[3]));
                        w.z = pk2(sigmoidf_(v1[0]), sigmoidf_(v1[1])); w.w = pk2(sigmoidf_(v1[2]), sigmoidf_(v1[3]));
                        *(u32x4*)(rowp + 32 * bj) = w; } }
        }
    }
};
struct EpiGate {
    static constexpr bool PERM = true;
    bf16_t* GATES; const float* b_gate;
    __device__ __forceinline__ void operator()(AccRef acc, const Unit& u, int wr, int wc, int fr_in, int fq_in) const {
        int fr = fr_in, fq = fq_in; asm volatile("" : "+v"(fr), "+v"(fq));
        const int row0 = u.pm * BM + wr * 64 + fr;
        const int col0 = u.pn * 256 + 64 * wc + 8 * fq;
#pragma unroll
        for (int ai = 0; ai < 2; ++ai)
#pragma unroll
            for (int m = 0; m < 4; ++m) { bf16_t* rowp = GATES + (size_t)(row0 + ai * HALF + m * 16) * 2048 + col0;
#pragma unroll
                for (int bj = 0; bj < 2; ++bj) { const f32x4 b0 = *(const f32x4*)(b_gate + col0 + 32 * bj), b1 = *(const f32x4*)(b_gate + col0 + 32 * bj + 4);
                    const f32x4 v0 = acc[ai][bj][m][0] * 0.03125f + b0, v1 = acc[ai][bj][m][1] * 0.03125f + b1;
                    u32x4 w; w.x = pk2(sigmoidf_(v0[0]), sigmoidf_(v0[1])); w.y = pk2(sigmoidf_(v0[2]), sigmoidf_(v0[3]));
                    w.z = pk2(sigmoidf_(v1[0]), sigmoidf_(v1[1])); w.w = pk2(sigmoidf_(v1[2]), sigmoidf_(v1[3]));
                    *(u32x4*)(rowp + 32 * bj) = w; } }
    }
};
struct EpiPlain {
    static constexpr bool PERM = true;
    bf16_t* O; size_t ldc;
    __device__ __forceinline__ void operator()(AccRef acc, const Unit& u, int wr, int wc, int fr, int fq) const {
        const int row0 = u.pm * BM + wr * 64 + fr, col0 = u.pn * BM + wc * 32 + 8 * fq;
#pragma unroll
        for (int ai = 0; ai < 2; ++ai)
#pragma unroll
            for (int m = 0; m < 4; ++m) { bf16_t* rowp = O + (size_t)(row0 + ai * HALF + m * 16) * ldc + col0;
#pragma unroll
                for (int bj = 0; bj < 2; ++bj) { const f32x4 v0 = acc[ai][bj][m][0], v1 = acc[ai][bj][m][1];
                    u32x4 w; w.x = pk2(v0[0], v0[1]); w.y = pk2(v0[2], v0[3]); w.z = pk2(v1[0], v1[1]); w.w = pk2(v1[2], v1[3]);
                    *(u32x4*)(rowp + bj * HALF) = w; } }
    }
};
struct EpiQKV {
    static constexpr bool PERM = true;
    EpiG1a e0; EpiPlain e1;
    __device__ __forceinline__ void operator()(AccRef acc, const Unit& u, int wr, int wc, int fr, int fq) const {
        if (u.br == 0) e0(acc, u, wr, wc, fr, fq); else e1(acc, u, wr, wc, fr, fq);
    }
};
struct EpiBranch {
    static constexpr bool PERM = true;
    bf16_t* MIX; const bf16_t* GATES;
    __device__ __forceinline__ void operator()(AccRef acc, const Unit& u, int wr, int wc, int fr, int fq) const {
        const int row0 = u.pm * BM + wr * 64 + fr, col0 = u.pn * BM + wc * 32 + 8 * fq;
#pragma unroll
        for (int ai = 0; ai < 2; ++ai)
#pragma unroll
            for (int m = 0; m < 4; ++m) { const size_t row = (size_t)(row0 + ai * HALF + m * 16);
#pragma unroll
                for (int bj = 0; bj < 2; ++bj) {
                    const u32x4 gw = *(const u32x4*)(GATES + row * 2048 + u.br * 1024 + col0 + bj * HALF);
                    const f32x4 a0 = acc[ai][bj][m][0], a1 = acc[ai][bj][m][1];
                    float r0 = a0[0] * bf_lo(gw.x), r1 = a0[1] * bf_hi(gw.x), r2 = a0[2] * bf_lo(gw.y), r3 = a0[3] * bf_hi(gw.y);
                    float r4 = a1[0] * bf_lo(gw.z), r5 = a1[1] * bf_hi(gw.z), r6 = a1[2] * bf_lo(gw.w), r7 = a1[3] * bf_hi(gw.w);
                    bf16_t* p = MIX + row * 1024 + col0 + bj * HALF;
                    if (u.br) { const u32x4 o = *(const u32x4*)p;
                        r0 += bf_lo(o.x); r1 += bf_hi(o.x); r2 += bf_lo(o.y); r3 += bf_hi(o.y); r4 += bf_lo(o.z); r5 += bf_hi(o.z); r6 += bf_lo(o.w); r7 += bf_hi(o.w); }
                    u32x4 w; w.x = pk2(r0, r1); w.y = pk2(r2, r3); w.z = pk2(r4, r5); w.w = pk2(r6, r7);
                    *(u32x4*)p = w; } }
    }
};
struct EpiRes {
    static constexpr bool PERM = false;
    const float* base; float* out; const float* gmod;
    __device__ __forceinline__ void operator()(AccRef acc, const Unit& u, int wr, int wc, int fr, int fq) const {
        const int row0 = u.pm * BM + wr * 64 + fr, col0 = u.pn * BM + wc * 32 + 4 * fq;
        const float* gm = gmod + (size_t)(u.pm >> 3) * NMOD + col0;
        f32x4 gv[2][2];
#pragma unroll
        for (int bj = 0; bj < 2; ++bj)
#pragma unroll
            for (int n = 0; n < 2; ++n) gv[bj][n] = *(const f32x4*)(gm + bj * HALF + n * 16);
#pragma unroll
        for (int ai = 0; ai < 2; ++ai)
#pragma unroll
            for (int m = 0; m < 4; ++m) { const size_t off = (size_t)(row0 + ai * HALF + m * 16) * DM + col0;
#pragma unroll
                for (int bj = 0; bj < 2; ++bj)
#pragma unroll
                    for (int n = 0; n < 2; ++n) { const f32x4 bs = *(const f32x4*)(base + off + bj * HALF + n * 16);
                        *(f32x4*)(out + off + bj * HALF + n * 16) = bs + gv[bj][n] * acc[ai][bj][m][n]; } }
    }
};
struct EpiUp {
    static constexpr bool PERM = true;
    bf16_t* ACT; const float* cw; const float* cb;
    __device__ __forceinline__ void operator()(AccRef acc, const Unit& u, int wr, int wc, int fr, int fq) const {
        const int lane = threadIdx.x & 63;
        const int srcL = ((lane & 48) | ((fr + 15) & 15)) * 4, srcR = ((lane & 48) | ((fr + 1) & 15)) * 4;
        const int fcol0 = u.pn * 128 + 32 * wc + 8 * fq;
#pragma unroll
        for (int n = 0; n < 2; ++n) {
            const int fc = fcol0 + 4 * n;
            const f32x4 wa0 = *(const f32x4*)(cw + fc), wa1 = *(const f32x4*)(cw + NUP + fc), wa2 = *(const f32x4*)(cw + 2 * NUP + fc), ba = *(const f32x4*)(cb + fc);
            const f32x4 wl0 = *(const f32x4*)(cw + DFF + fc), wl1 = *(const f32x4*)(cw + NUP + DFF + fc), wl2 = *(const f32x4*)(cw + 2 * NUP + DFF + fc), bl = *(const f32x4*)(cb + DFF + fc);
#pragma unroll
            for (int ai = 0; ai < 2; ++ai) {
                const int gb = u.pm * 248 + 62 * (2 * ai + wr) - 1;
#pragma unroll
                for (int m = 0; m < 4; ++m) {
                    int j = 16 * m + fr; asm volatile("" : "+v"(j));
                    const int grow = gb + j;
                    const bool hasL = (grow & 2047) != 0, hasR = (grow & 2047) != 2047;
                    f32x4 ua, ul;
                    const bool edge = __any(!(hasL && hasR));
#pragma unroll
                    for (int e = 0; e < 4; ++e) {
#pragma unroll
                        for (int bj = 0; bj < 2; ++bj) {
                            const float c = acc[ai][bj][m][n][e];
                            const float oldL = (m > 0) ? dpp_rr1(acc[ai][bj][m > 0 ? m - 1 : 0][n][e]) : 0.f;
                            const float oldR = (m < 3) ? dpp_rr15(acc[ai][bj][m < 3 ? m + 1 : 3][n][e]) : 0.f;
                            float Lv = dpp_shr1(oldL, c), Rv = dpp_shl1(oldR, c);
                            if (edge) { Lv = hasL ? Lv : 0.f; Rv = hasR ? Rv : 0.f; }
                            if (bj == 0) ua[e] = (ba[e] + wa1[e] * c) + (wa0[e] * Lv + wa2[e] * Rv);
                            else         ul[e] = (bl[e] + wl1[e] * c) + (wl0[e] * Lv + wl2[e] * Rv);
                        }
                    }
                    const f32x2 g0 = gelu_pk((f32x2){ua[0], ua[1]}), g1 = gelu_pk((f32x2){ua[2], ua[3]});
                    u32x2 w; w.x = pk2(g0.x * ul[0], g0.y * ul[1]); w.y = pk2(g1.x * ul[2], g1.y * ul[3]);
                    if (j >= 1 && j <= 62 && grow < M_TOK) *(u32x2*)(ACT + (size_t)grow * DFF + fc) = w;
                }
            }
        }
    }
};
}

#define LDS_WAIT() asm volatile("s_waitcnt lgkmcnt(0)" ::: "memory")
__device__ __forceinline__ void transpose_item(const float* W, int Nsrc, int k0, int srccol, bf16_t* WT, int Kdst, int dstrow, LAS float* scr, int lane) {
    f32x4 ld_[8];
#pragma unroll
    for (int i = 0; i < 8; ++i) ld_[i] = *(const f32x4*)(W + (size_t)(k0 + (lane >> 3) + 8 * i) * Nsrc + srccol + 4 * (lane & 7));
#pragma unroll
    for (int i = 0; i < 8; ++i) { LAS float* d_ = scr + ((lane >> 3) + 8 * i) * 33 + 4 * (lane & 7); d_[0] = ld_[i][0]; d_[1] = ld_[i][1]; d_[2] = ld_[i][2]; d_[3] = ld_[i][3]; }
    LDS_WAIT(); asm volatile("" ::: "memory");
    const int c = lane & 7;
#pragma unroll
    for (int j = 0; j < 4; ++j) { const int n = (lane >> 3) + 8 * j; const LAS float* s = scr + (8 * c) * 33 + n;
        u32x4 o; o.x = pk2(s[0 * 33], s[1 * 33]); o.y = pk2(s[2 * 33], s[3 * 33]); o.z = pk2(s[4 * 33], s[5 * 33]); o.w = pk2(s[6 * 33], s[7 * 33]);
        *(u32x4*)(WT + (size_t)(dstrow + n) * Kdst + k0 + 8 * c) = o; }
    LDS_WAIT(); asm volatile("" ::: "memory");
}
__device__ __forceinline__ unsigned pk4_fp8(float a, float b, float c, float d) { int p = __builtin_amdgcn_cvt_pk_fp8_f32(a, b, 0, false); p = __builtin_amdgcn_cvt_pk_fp8_f32(c, d, p, true); return (unsigned)p; }
__device__ __forceinline__ void transpose_item_fp8(const float* W, int Nsrc, int k0, int srccol, unsigned char* WT8, int Kdst, int dstrow, float scale, LAS float* scr, int lane) {
    f32x4 ld_[8];
#pragma unroll
    for (int i = 0; i < 8; ++i) ld_[i] = *(const f32x4*)(W + (size_t)(k0 + (lane >> 3) + 8 * i) * Nsrc + srccol + 4 * (lane & 7));
#pragma unroll
    for (int i = 0; i < 8; ++i) { LAS float* d_ = scr + ((lane >> 3) + 8 * i) * 33 + 4 * (lane & 7); d_[0] = ld_[i][0] * scale; d_[1] = ld_[i][1] * scale; d_[2] = ld_[i][2] * scale; d_[3] = ld_[i][3] * scale; }
    LDS_WAIT(); asm volatile("" ::: "memory");
    const int c = lane & 7;
#pragma unroll
    for (int j = 0; j < 4; ++j) { const int n = (lane >> 3) + 8 * j; const LAS float* s = scr + (8 * c) * 33 + n;
        u32x2 o; o.x = pk4_fp8(s[0 * 33], s[1 * 33], s[2 * 33], s[3 * 33]); o.y = pk4_fp8(s[4 * 33], s[5 * 33], s[6 * 33], s[7 * 33]);
        *(u32x2*)(WT8 + (size_t)(dstrow + n) * Kdst + k0 + 8 * c) = o; }
    LDS_WAIT(); asm volatile("" ::: "memory");
}
__device__ __forceinline__ void mod_item(const Args& a, float* mod, int nb, int kc, LAS float* scr, int lane) {
    const int n0 = nb * 64, k0 = kc * 64;
#pragma unroll 4
    for (int b = 0; b < 32; ++b) { const float v = a.c[b * DM + k0 + lane]; scr[lane * 32 + b] = v * sigmoidf_(v); }
    LDS_WAIT(); asm volatile("" ::: "memory");
    float acc[32];
#pragma unroll
    for (int b = 0; b < 32; ++b) acc[b] = 0.f;
#pragma unroll 4
    for (int k = 0; k < 64; ++k) {
        const float w = a.ada_w[(size_t)(k0 + k) * NMOD + n0 + lane];
#pragma unroll
        for (int b4 = 0; b4 < 8; ++b4) { const f32x4 cv = *(const LAS f32x4*)(scr + k * 32 + 4 * b4);
            acc[4 * b4 + 0] += cv[0] * w; acc[4 * b4 + 1] += cv[1] * w; acc[4 * b4 + 2] += cv[2] * w; acc[4 * b4 + 3] += cv[3] * w; }
    }
    const float bias = (kc == 0) ? a.ada_b[n0 + lane] : 0.f;
#pragma unroll
    for (int b = 0; b < 32; ++b) atomicAdd(mod + (size_t)b * NMOD + n0 + lane, acc[b] + bias);
    LDS_WAIT(); asm volatile("" ::: "memory");
}
template <bool WITH_FP8 = false> __device__ __forceinline__ void norm_rows(const float* X, const float* gain, const float* mod, int sh_off, int sc_off, bf16_t* Hout, int gw, int NGW, int lane, int mbeg = 0, int mend = M_TOK, unsigned char* H8out = nullptr) {
    for (int m0 = mbeg + 2 * gw; m0 < mend; m0 += 2 * NGW) {
        f32x4 v[2][4]; float ss[2];
#pragma unroll
        for (int q = 0; q < 2; ++q) { const f32x4* xr = (const f32x4*)(X + (size_t)(m0 + q) * DM) + lane;
#pragma unroll
            for (int j = 0; j < 4; ++j) v[q][j] = xr[64 * j]; }
#pragma unroll
        for (int q = 0; q < 2; ++q) { float s_ = 0.f;
#pragma unroll
            for (int j = 0; j < 4; ++j) s_ += (v[q][j][0] * v[q][j][0] + v[q][j][1] * v[q][j][1]) + (v[q][j][2] * v[q][j][2] + v[q][j][3] * v[q][j][3]);
            ss[q] = rsqrtf(wave_sum(s_) * (1.0f / DM) + EPS); }
        const float* mb = mod + (size_t)(m0 >> 11) * NMOD;
#pragma unroll
        for (int j = 0; j < 4; ++j) { const int col = 4 * lane + 256 * j;
            const f32x4 g = *(const f32x4*)(gain + col), sc = *(const f32x4*)(mb + sc_off + col) + 1.0f, sh = *(const f32x4*)(mb + sh_off + col);
            const f32x4 gs = g * sc;
#pragma unroll
            for (int q = 0; q < 2; ++q) { const f32x4 y = v[q][j] * ss[q] * gs + sh;
                u32x2 w; w.x = pk2(y[0], y[1]); w.y = pk2(y[2], y[3]); ((u32x2*)(Hout + (size_t)(m0 + q) * DM) + lane)[64 * j] = w;
                if constexpr (WITH_FP8) ((unsigned*)(H8out + (size_t)(m0 + q) * DM) + lane)[64 * j] = pk4_fp8(y[0], y[1], y[2], y[3]); } }
    }
}

__device__ __forceinline__ bf16x8 ld16(const bf16_t* p) { return *(const bf16x8*)p; }
__device__ __forceinline__ bf16x8 pack8(float a0, float a1, float a2, float a3, float a4, float a5, float a6, float a7) {
    u32x4 w; w.x = pk2(a0, a1); w.y = pk2(a2, a3); w.z = pk2(a4, a5); w.w = pk2(a6, a7); return __builtin_bit_cast(bf16x8, w);
}
__device__ __forceinline__ void na_unit(const bf16_t* QK, const bf16_t* VT, const float* rpb, bf16_t* Y, int b, int h, int r, int cgp, int lane) {
    const int fr = lane & 15, fq = lane >> 4;
    int r0 = r - 4; r0 = r0 < 0 ? 0 : (r0 > 24 ? 24 : r0);
    const int c0 = 16 * cgp, w0 = (cgp == 0) ? 0 : (cgp == 1) ? 8 : (cgp == 2) ? 24 : 32;
    const int tokb = b * SEQ;
    const int qrow = tokb + r * 64 + c0 + fr;
    bf16x8 qf[2];
#pragma unroll
    for (int ks = 0; ks < 2; ++ks) qf[ks] = ld16(QK + (size_t)qrow * 2048 + h * 64 + 32 * ks + 8 * fq);
    f32x4 s[8][2];
#pragma unroll
    for (int i = 0; i < 8; ++i)
#pragma unroll
        for (int t = 0; t < 2; ++t) {
            const int kcolA = w0 + 8 * (fr >> 2) + 4 * t + (fr & 3);
            const bf16_t* kp = QK + (size_t)(tokb + (r0 + i) * 64 + kcolA) * 2048 + 512 + h * 64 + 8 * fq;
            const bf16x8 a0 = ld16(kp), a1 = ld16(kp + 32);
            f32x4 acc = {0.f, 0.f, 0.f, 0.f};
            acc = __builtin_amdgcn_mfma_f32_16x16x32_bf16(a0, qf[0], acc, 0, 0, 0);
            acc = __builtin_amdgcn_mfma_f32_16x16x32_bf16(a1, qf[1], acc, 0, 0, 0);
            s[i][t] = acc;
        }
    const int qc = c0 + fr; int cs = qc - 8; cs = cs < 0 ? 0 : (cs > 48 ? 48 : cs);
    float mx = -1e30f;
#pragma unroll
    for (int i = 0; i < 8; ++i) {
        const float* bp = rpb + (size_t)(h * 15 + (r0 + i - r + 7)) * 31;
#pragma unroll
        for (int t = 0; t < 2; ++t)
#pragma unroll
            for (int j = 0; j < 4; ++j) {
                const int kcol = w0 + 8 * fq + 4 * t + j;
                const bool valid = (kcol >= cs) && (kcol < cs + 16);
                int dc = kcol - qc + 15; dc = dc < 0 ? 0 : (dc > 30 ? 30 : dc);
                const float v = valid ? (s[i][t][j] + bp[dc] * LOG2E) : -1e30f;
                s[i][t][j] = v; mx = fmaxf(mx, v);
            }
    }
    mx = fmaxf(mx, __shfl_xor(mx, 16)); mx = fmaxf(mx, __shfl_xor(mx, 32));
    float sum = 0.f;
#pragma unroll
    for (int i = 0; i < 8; ++i)
#pragma unroll
        for (int t = 0; t < 2; ++t)
#pragma unroll
            for (int j = 0; j < 4; ++j) { const float p = __builtin_amdgcn_exp2f(s[i][t][j] - mx); s[i][t][j] = p; sum += p; }
    sum += __shfl_xor(sum, 16); sum += __shfl_xor(sum, 32);
    const float inv = 1.0f / sum;
    f32x4 o[4];
#pragma unroll
    for (int dt = 0; dt < 4; ++dt) o[dt] = (f32x4){0.f, 0.f, 0.f, 0.f};
#pragma unroll
    for (int i = 0; i < 8; ++i) {
        const bf16x8 pb = pack8(s[i][0][0], s[i][0][1], s[i][0][2], s[i][0][3], s[i][1][0], s[i][1][1], s[i][1][2], s[i][1][3]);
        const bf16_t* vp = VT + (size_t)(h * 64 + fr) * M_TOK + tokb + (r0 + i) * 64 + w0 + 8 * fq;
#pragma unroll
        for (int dt = 0; dt < 4; ++dt) { const bf16x8 va = ld16(vp + (size_t)(16 * dt) * M_TOK);
            o[dt] = __builtin_amdgcn_mfma_f32_16x16x32_bf16(va, pb, o[dt], 0, 0, 0); }
    }
    bf16_t* yp = Y + (size_t)qrow * 1024 + h * 64 + 4 * fq;
#pragma unroll
    for (int dt = 0; dt < 4; ++dt) { u32x2 w; w.x = pk2(o[dt][0] * inv, o[dt][1] * inv); w.y = pk2(o[dt][2] * inv, o[dt][3] * inv); *(u32x2*)(yp + 16 * dt) = w; }
}

__device__ __forceinline__ void df_unit(const bf16_t* QK, const bf16_t* VT, const float* subg, bf16_t* Y, int b, int h, int qb, float lam, LAS float* park, int lane) {
    const int r32 = lane & 31, hi = lane >> 5;
    const int q0 = qb * 32, tokb = b * SEQ;
    const float slope2 = __builtin_amdgcn_exp2f(-2.0f * (float)(h + 1)) * LOG2E;
    const int phi = (r32 & 19) | ((r32 & 4) << 1) | ((r32 & 8) >> 1);
    f32x16 O[4];
#pragma unroll 1
    for (int c = 0; c < 2; ++c) {
        bf16x8 qf[4];
#pragma unroll
        for (int d0 = 0; d0 < 4; ++d0) qf[d0] = ld16(QK + (size_t)(tokb + q0 + r32) * 2048 + 1024 + h * 128 + c * 64 + 16 * d0 + 8 * hi);
#pragma unroll
        for (int d = 0; d < 4; ++d)
#pragma unroll
            for (int r = 0; r < 16; ++r) O[d][r] = 0.f;
        float mrun = -1e30f, l = 0.f;
        const bf16_t* kbase = QK + (size_t)(tokb + phi) * 2048 + 1536 + h * 128 + c * 64 + 8 * hi;
        const bf16_t* vbase = VT + (size_t)(512 + h * 128 + r32) * M_TOK + tokb + 8 * hi;
#pragma unroll 1
        for (int kt = 0; kt < SEQ / 64; ++kt) {
            const int kv0 = kt * 64;
            f32x16 S[2];
#pragma unroll
            for (int sub = 0; sub < 2; ++sub) {
#pragma unroll
                for (int r = 0; r < 16; ++r) S[sub][r] = 0.f;
#pragma unroll
                for (int d0 = 0; d0 < 4; ++d0) { const bf16x8 kf = ld16(kbase + (size_t)(kv0 + 32 * sub) * 2048 + 16 * d0);
                    S[sub] = __builtin_amdgcn_mfma_f32_32x32x16_bf16(kf, qf[d0], S[sub], 0, 0, 0); }
            }
            const float base = (float)(kv0 + 8 * hi - q0 - r32);
            float mx = -1e30f;
#pragma unroll
            for (int sub = 0; sub < 2; ++sub)
#pragma unroll
                for (int r = 0; r < 16; ++r) { const float t = base + (float)(32 * sub + (r & 7) + 16 * (r >> 3));
                    const float v = S[sub][r] - slope2 * fabsf(t); S[sub][r] = v; mx = fmaxf(mx, v); }
            mx = fmaxf(mx, __shfl_xor(mx, 32));
            const float mnew = fmaxf(mrun, mx), alpha = __builtin_amdgcn_exp2f(mrun - mnew); mrun = mnew;
            float rs = 0.f;
#pragma unroll
            for (int sub = 0; sub < 2; ++sub)
#pragma unroll
                for (int r = 0; r < 16; ++r) { const float p = __builtin_amdgcn_exp2f(S[sub][r] - mnew); S[sub][r] = p; rs += p; }
            l = l * alpha + rs;
#pragma unroll
            for (int d = 0; d < 4; ++d)
#pragma unroll
                for (int r = 0; r < 16; ++r) O[d][r] *= alpha;
            bf16x8 pb[2][2];
#pragma unroll
            for (int sub = 0; sub < 2; ++sub)
#pragma unroll
                for (int sl = 0; sl < 2; ++sl) pb[sub][sl] = pack8(S[sub][8 * sl + 0], S[sub][8 * sl + 1], S[sub][8 * sl + 2], S[sub][8 * sl + 3], S[sub][8 * sl + 4], S[sub][8 * sl + 5], S[sub][8 * sl + 6], S[sub][8 * sl + 7]);
#pragma unroll
            for (int d = 0; d < 4; ++d) {
                if (d == 2) __builtin_amdgcn_sched_barrier(0);
#pragma unroll
                for (int sub = 0; sub < 2; ++sub)
#pragma unroll
                    for (int sl = 0; sl < 2; ++sl) { const bf16x8 va = ld16(vbase + (size_t)(32 * d) * M_TOK + kv0 + 32 * sub + 16 * sl);
                        O[d] = __builtin_amdgcn_mfma_f32_32x32x16_bf16(va, pb[sub][sl], O[d], 0, 0, 0); }
            }
        }
        l += __shfl_xor(l, 32);
        const float inv = 1.0f / l;
        if (c == 0) {
#pragma unroll
            for (int d = 0; d < 4; ++d)
#pragma unroll
                for (int r = 0; r < 16; ++r) park[(d * 16 + r) * 64 + lane] = O[d][r] * inv;
        } else {
            LDS_WAIT();
            float ss = 0.f;
#pragma unroll
            for (int d = 0; d < 4; ++d)
#pragma unroll
                for (int r = 0; r < 16; ++r) { const float v = park[(d * 16 + r) * 64 + lane] - lam * (O[d][r] * inv); O[d][r] = v; ss += v * v; }
            ss += __shfl_xor(ss, 32);
            const float rstd = rsqrtf(ss * (1.0f / 128.0f) + EPS) * 0.8f;
            bf16_t* yp = Y + (size_t)(tokb + q0 + r32) * 1024 + 512 + h * 128 + 4 * hi;
#pragma unroll
            for (int d = 0; d < 4; ++d)
#pragma unroll
                for (int g = 0; g < 4; ++g) { const int dcol = 32 * d + 8 * g + 4 * hi; const f32x4 sg = *(const f32x4*)(subg + dcol);
                    u32x2 w; w.x = pk2(O[d][4 * g + 0] * rstd * sg[0], O[d][4 * g + 1] * rstd * sg[1]); w.y = pk2(O[d][4 * g + 2] * rstd * sg[2], O[d][4 * g + 3] * rstd * sg[3]);
                    *(u32x2*)(yp + 32 * d + 8 * g) = w; }
            LDS_WAIT();
        }
    }
}


constexpr int DF_STAGE = 24576, DF_NST = 3;
#define DF_WAIT_V(n) asm volatile("s_waitcnt vmcnt(" #n ")" ::: "memory")
__device__ __forceinline__ void df_block(LAS unsigned char* lds, const bf16_t* QK, const bf16_t* VT, const float* subg, const float* gtab, bf16_t* Y, float* parkg, float lam, int G, int vcu, int wave, int lane) {
    const int r32 = lane & 31, hi = lane >> 5;
    const int phi = (r32 & 19) | ((r32 & 4) << 1) | ((r32 & 8) >> 1);
    float Bst;
    { float gq = fabsf(gtab[128 + lane]), gk = fabsf(gtab[192 + lane]);
#pragma unroll
      for (int o = 1; o < 64; o <<= 1) { gq = fmaxf(gq, __shfl_xor(gq, o)); gk = fmaxf(gk, __shfl_xor(gk, o)); }
      Bst = 11.6f * gq * gk + 0.5f; }
    const int prow = 8 * wave + (lane >> 3), pc = lane & 7;
    const size_t ksrc = (size_t)prow * 2048 + (size_t)((pc ^ ((prow >> 1) & 7)) * 8);
    const size_t vsrc0 = (size_t)prow * M_TOK + (size_t)((pc ^ ((prow >> 1) & 7)) * 8);
    const size_t vsrc1 = (size_t)(prow + 64) * M_TOK + (size_t)((pc ^ (((prow + 64) >> 1) & 7)) * 8);
    const int kx = (phi >> 1) & 7, vx = (r32 >> 1) & 7;
    const int koff0 = phi * 128 + ((hi ^ kx) * 16), voff0 = 8192 + r32 * 128 + ((hi ^ vx) * 16);
    float* park = parkg + (size_t)(vcu * NWAVES + wave) * 4096;
    for (int u = vcu; u < NBATCH * 4 * 8 * ((DUP_MASK & 8) ? 2 : 1); u += G) {
        const int up_ = u & 255, qblk = up_ & 7, b = up_ >> 3, h = ((u >> 8) + up_) & 3;
        const int tokb = b * SEQ, q0w = qblk * 256 + wave * 32;
        const float slope2 = __builtin_amdgcn_exp2f(-2.0f * (float)(h + 1)) * LOG2E;
        const bf16_t* Kg = QK + (size_t)tokb * 2048 + 1536 + h * 128;
        const bf16_t* Vg = VT + (size_t)(512 + h * 128) * M_TOK + tokb;
        const int kvmix = q0w & ~63;
        const float tqf = (float)(8 * hi - q0w - r32);
        const int Dk = (int)(160.0f / slope2) + 2;
        int kt_lo = (qblk * 256 - Dk - 63 + 63) >> 6; kt_lo = kt_lo < 0 ? 0 : kt_lo;
        int kt_hi = (qblk * 256 + 255 + Dk) >> 6; kt_hi = kt_hi > 31 ? 31 : kt_hi;
        const int NT = kt_hi - kt_lo + 1, NG = 2 * NT;
#define DF_ISSUE(g_) do { const int c_ = ((g_) >= NT) ? 1 : 0, kt_ = kt_lo + (g_) - c_ * NT, st_ = (g_) % DF_NST; LAS unsigned char* sb_ = lds + st_ * DF_STAGE + wave * 1024; \
            __builtin_amdgcn_global_load_lds((const unsigned*)(Kg + (size_t)kt_ * 64 * 2048 + c_ * 64 + ksrc), (LAS unsigned*)(sb_), 16, 0, 0); \
            __builtin_amdgcn_global_load_lds((const unsigned*)(Vg + kt_ * 64 + vsrc0), (LAS unsigned*)(sb_ + 8192), 16, 0, 0); \
            __builtin_amdgcn_global_load_lds((const unsigned*)(Vg + kt_ * 64 + vsrc1), (LAS unsigned*)(sb_ + 16384), 16, 0, 0); } while (0)
        DF_ISSUE(0); DF_ISSUE(1);
#pragma unroll 1
        for (int c = 0; c < 2; ++c) {
            f32x16 O[4], Dp; bf16x8 qf[4]; float l = 0.f;
#pragma unroll
            for (int d0 = 0; d0 < 4; ++d0) qf[d0] = ld16(QK + (size_t)(tokb + q0w + r32) * 2048 + 1024 + h * 128 + c * 64 + 16 * d0 + 8 * hi);
#pragma unroll
            for (int d = 0; d < 4; ++d)
#pragma unroll
                for (int r = 0; r < 16; ++r) O[d][r] = 0.f;
#pragma unroll
            for (int r = 0; r < 16; ++r) Dp[r] = slope2 * (float)((r & 7) + 16 * (r >> 3));
#pragma unroll 1
            for (int kt = kt_lo; kt <= kt_hi; ++kt) {
                const int g = c * NT + (kt - kt_lo), kv0 = kt * 64;
                if (kt == kt_lo || g == NG - 1) { DF_WAIT_V(0); } else { DF_WAIT_V(3); }
                __builtin_amdgcn_s_barrier();
                asm volatile("" ::: "memory");
                if (g + 2 < NG) DF_ISSUE(g + 2);
                LAS unsigned char* st = lds + (g % DF_NST) * DF_STAGE;
                int kb_ = koff0, vb_ = voff0; asm volatile("" : "+v"(kb_), "+v"(vb_));
                const bool mixed = (kv0 == kvmix);
                float base = (float)kv0 + tqf; asm volatile("" : "+v"(base));
                f32x2 rs2 = {0.f, 0.f};
#pragma unroll
                for (int sub = 0; sub < 2; ++sub) {
                    f32x16 S = Dp;
#pragma unroll
                    for (int d0 = 0; d0 < 4; ++d0) { const bf16x8 kf = *(const LAS bf16x8*)(st + sub * 4096 + (kb_ ^ (32 * d0)));
                        S = __builtin_amdgcn_mfma_f32_32x32x16_bf16(kf, qf[d0], S, 0, 0, 0); }
                    if (mixed) {
#pragma unroll
                        for (int r = 0; r < 16; ++r) { const float t = base + (float)(32 * sub + (r & 7) + 16 * (r >> 3));
                            S[r] = __builtin_amdgcn_exp2f(((S[r] - Dp[r]) - Bst) - slope2 * fabsf(t)); }
                    } else {
                        const float e0 = slope2 * (base + (float)(32 * sub));
                        const float E = (kv0 < kvmix ? e0 : -e0) - Bst;
                        const f32x2 E2 = {E, E};
#pragma unroll
                        for (int r = 0; r < 16; r += 2) { const f32x2 t2 = (f32x2){S[r], S[r + 1]} + E2;
                            S[r] = __builtin_amdgcn_exp2f(t2.x); S[r + 1] = __builtin_amdgcn_exp2f(t2.y); }
                    }
#pragma unroll
                    for (int r = 0; r < 16; r += 2) rs2 += (f32x2){S[r], S[r + 1]};
                    bf16x8 pb[2];
#pragma unroll
                    for (int sl = 0; sl < 2; ++sl)
                        pb[sl] = pack8(S[8 * sl + 0], S[8 * sl + 1], S[8 * sl + 2], S[8 * sl + 3], S[8 * sl + 4], S[8 * sl + 5], S[8 * sl + 6], S[8 * sl + 7]);
#pragma unroll
                    for (int d = 0; d < 4; ++d)
#pragma unroll
                        for (int sl = 0; sl < 2; ++sl) { const bf16x8 va = *(const LAS bf16x8*)(st + d * 4096 + (vb_ ^ (32 * (2 * sub + sl))));
                            O[d] = __builtin_amdgcn_mfma_f32_32x32x16_bf16(va, pb[sl], O[d], 0, 0, 0); }
                }
                l += rs2.x + rs2.y;
                if (mixed) {
                    asm volatile("" ::: "memory");
#pragma unroll
                    for (int r = 0; r < 16; ++r) Dp[r] = -Dp[r];
                }
            }
            l += __shfl_xor(l, 32);
            const float inv = 1.0f / l;
            float* pp = park + lane * 4; asm volatile("" : "+v"(pp));
            if (c == 0) {
#pragma unroll
                for (int d = 0; d < 4; ++d)
#pragma unroll
                    for (int q4 = 0; q4 < 4; ++q4) *(f32x4*)(pp + (d * 4 + q4) * 256) = (f32x4){O[d][4 * q4 + 0] * inv, O[d][4 * q4 + 1] * inv, O[d][4 * q4 + 2] * inv, O[d][4 * q4 + 3] * inv};
            } else {
                float ss = 0.f;
#pragma unroll
                for (int d = 0; d < 4; ++d)
#pragma unroll
                    for (int q4 = 0; q4 < 4; ++q4) { const f32x4 pk = *(const f32x4*)(pp + (d * 4 + q4) * 256);
#pragma unroll
                        for (int e = 0; e < 4; ++e) { const float v = pk[e] - lam * (O[d][4 * q4 + e] * inv); O[d][4 * q4 + e] = v; ss += v * v; } }
                ss += __shfl_xor(ss, 32);
                const float rstd = rsqrtf(ss * (1.0f / 128.0f) + EPS) * 0.8f;
                bf16_t* yp = Y + (size_t)(tokb + q0w + r32) * 1024 + 512 + h * 128 + 4 * hi;
#pragma unroll
                for (int d = 0; d < 4; ++d)
#pragma unroll
                    for (int gq4 = 0; gq4 < 4; ++gq4) { const int dcol = 32 * d + 8 * gq4 + 4 * hi; const f32x4 sg = *(const f32x4*)(subg + dcol);
                        u32x2 w; w.x = pk2(O[d][4 * gq4 + 0] * rstd * sg[0], O[d][4 * gq4 + 1] * rstd * sg[1]); w.y = pk2(O[d][4 * gq4 + 2] * rstd * sg[2], O[d][4 * gq4 + 3] * rstd * sg[3]);
                        *(u32x2*)(yp + 32 * d + 8 * gq4) = w; }
            }
        }
        asm volatile("s_waitcnt lgkmcnt(0)" ::: "memory");
        __builtin_amdgcn_s_barrier();
#undef DF_ISSUE
    }
}


constexpr int NA_STAGE = 16384, NA_NST = 4, NA_TAB = 65536;
__device__ __forceinline__ void na_block(LAS unsigned char* lds, const bf16_t* QK, const bf16_t* VT, const float* rpb, const float* gtab, bf16_t* Y, int G, int vcu, int wave, int lane) {
    const int fr = lane & 15, fq = lane >> 4, tid = wave * 64 + lane;
    float Bqk;
    { float gq = fabsf(gtab[lane]), gk = fabsf(gtab[64 + lane]);
#pragma unroll
      for (int o = 1; o < 64; o <<= 1) { gq = fmaxf(gq, __shfl_xor(gq, o)); gk = fmaxf(gk, __shfl_xor(gk, o)); }
      Bqk = 11.6f * gq * gk + 0.5f; }
    LAS float* tab = (LAS float*)(lds + NA_TAB);
    const int prow = 8 * wave + (lane >> 3), pch = ((lane & 7) ^ ((prow >> 1) & 7)) * 8;
    const size_t ksrc = (size_t)prow * 2048 + pch, vsrc = (size_t)prow * M_TOK + pch;
    int koff[4][2], voff[4], w0s[4];
#pragma unroll
    for (int tk = 0; tk < 4; ++tk) { const int w0 = (tk == 0) ? 0 : (tk == 1) ? 8 : (tk == 2) ? 24 : 32; w0s[tk] = w0;
#pragma unroll
        for (int t = 0; t < 2; ++t) { const int kc = w0 + 8 * (fr >> 2) + 4 * t + (fr & 3); koff[tk][t] = kc * 128 + ((fq ^ ((kc >> 1) & 7)) * 16); }
        voff[tk] = 8192 + fr * 128 + ((((w0 >> 3) + fq) ^ ((fr >> 1) & 7)) * 16); }
    int hcur = -1; float Bst = 0.f;
    int tbase[4];
#pragma unroll
    for (int tk = 0; tk < 4; ++tk) { const int qc = 16 * tk + fr; const int v = qc < 8 ? 1 + qc : (qc > 56 ? qc - 48 : 0);
        tbase[tk] = NA_TAB + v * 3840 + (w0s[tk] + 8 * fq - qc + 31) * 4; }
    for (int u = vcu; u < NBATCH * 8 * 4 * ((DUP_MASK & 256) ? 2 : 1); u += G) {
        const int band = u & 3, h = (u >> 2) & 7, b = (u >> 5) & 31;
        if (h != hcur) {
            hcur = h;
    { float mxb = 0.f;
      for (int i = lane; i < 15 * 31; i += 64) mxb = fmaxf(mxb, fabsf(rpb[h * 465 + i]));
#pragma unroll
      for (int o = 1; o < 64; o <<= 1) mxb = fmaxf(mxb, __shfl_xor(mxb, o));
      Bst = Bqk + LOG2E * mxb; }
    for (int i = tid; i < 16 * 15 * 64; i += 512) { const int v = i / 960, rem = i - v * 960, dr = rem >> 6, dc = (rem & 63) - 16;
        const int qcv = (v == 0) ? 32 : (v <= 8 ? v - 1 : 48 + v); int cs = qcv - 8; cs = cs < 0 ? 0 : (cs > 48 ? 48 : cs);
        const int dlo = cs - qcv + 15; const bool ok = (dc >= dlo) && (dc < dlo + 16);
        int dcc = dc < 0 ? 0 : (dc > 30 ? 30 : dc);
        const float val = rpb[(h * 15 + dr) * 31 + dcc] * LOG2E - Bst;
        tab[i] = ok ? val : -1e30f; }
            asm volatile("s_waitcnt lgkmcnt(0)" ::: "memory"); __builtin_amdgcn_s_barrier();
        }
        const int R0 = 8 * band, r = R0 + wave, tokb = b * SEQ;
        int r0 = r - 4; r0 = r0 < 0 ? 0 : (r0 > 24 ? 24 : r0);
        int klo = R0 - 4; klo = klo < 0 ? 0 : klo;
        int khi = R0 + 3; khi = (khi > 24 ? 24 : khi) + 7;
        const int nsteps = khi - klo + 1;
        const bf16_t* Kg = QK + (size_t)(tokb + klo * 64) * 2048 + 512 + h * 64;
        const bf16_t* Vg = VT + (size_t)(h * 64) * M_TOK + tokb + klo * 64;
        bf16x8 qf[4][2];
#pragma unroll
        for (int tk = 0; tk < 4; ++tk)
#pragma unroll
            for (int ks = 0; ks < 2; ++ks) qf[tk][ks] = ld16(QK + (size_t)(tokb + r * 64 + 16 * tk + fr) * 2048 + h * 64 + 32 * ks + 8 * fq);
#define NA_ISSUE(s_) do { LAS unsigned char* sb_ = lds + ((s_) & 3) * NA_STAGE + wave * 1024; \
            __builtin_amdgcn_global_load_lds((const unsigned*)(Kg + (size_t)(s_) * 64 * 2048 + ksrc), (LAS unsigned*)(sb_), 16, 0, 0); \
            __builtin_amdgcn_global_load_lds((const unsigned*)(Vg + (s_) * 64 + vsrc), (LAS unsigned*)(sb_ + 8192), 16, 0, 0); } while (0)
        NA_ISSUE(0); NA_ISSUE(1); NA_ISSUE(2);
        f32x4 O[4][4]; float l[4];
#pragma unroll
        for (int tk = 0; tk < 4; ++tk) { l[tk] = 0.f;
#pragma unroll
            for (int dt = 0; dt < 4; ++dt) O[tk][dt] = (f32x4){0.f, 0.f, 0.f, 0.f}; }
#pragma unroll 1
        for (int s_ = 0; s_ < nsteps; ++s_) {
            if (s_ + 2 < nsteps) { asm volatile("s_waitcnt vmcnt(4)" ::: "memory"); } else if (s_ + 1 < nsteps) { asm volatile("s_waitcnt vmcnt(2)" ::: "memory"); } else { asm volatile("s_waitcnt vmcnt(0)" ::: "memory"); }
            asm volatile("s_waitcnt lgkmcnt(0)" ::: "memory");
            __builtin_amdgcn_s_barrier();
            asm volatile("" ::: "memory");
            if (s_ + 3 < nsteps) NA_ISSUE(s_ + 3);
            const int kr = klo + s_;
            if (kr >= r0 && kr < r0 + 8) {
                LAS unsigned char* st = lds + (s_ & 3) * NA_STAGE;
                const int droff = (kr - r + 7) * 256;
#pragma unroll
                for (int tk = 0; tk < 4; ++tk) {
                    f32x4 sv[2]; const int tb = tbase[tk] + droff;
#pragma unroll
                    for (int t = 0; t < 2; ++t) {
                        const bf16x8 a0 = *(const LAS bf16x8*)(st + koff[tk][t]), a1 = *(const LAS bf16x8*)(st + (koff[tk][t] ^ 64));
                        f32x4 acc = {0.f, 0.f, 0.f, 0.f};
                        acc = __builtin_amdgcn_mfma_f32_16x16x32_bf16(a0, qf[tk][0], acc, 0, 0, 0);
                        acc = __builtin_amdgcn_mfma_f32_16x16x32_bf16(a1, qf[tk][1], acc, 0, 0, 0);
                        sv[t] = acc;
                    }
                    float ps = 0.f;
#pragma unroll
                    for (int t = 0; t < 2; ++t)
#pragma unroll
                        for (int j = 0; j < 4; ++j) { const float bb = *(const LAS float*)(lds + tb + (4 * t + j) * 4);
                            const float p = __builtin_amdgcn_exp2f(sv[t][j] + bb); sv[t][j] = p; ps += p; }
                    l[tk] += ps;
                    const bf16x8 pb = pack8(sv[0][0], sv[0][1], sv[0][2], sv[0][3], sv[1][0], sv[1][1], sv[1][2], sv[1][3]);
#pragma unroll
                    for (int dt = 0; dt < 4; ++dt) { const bf16x8 va = *(const LAS bf16x8*)(st + voff[tk] + dt * 2048);
                        O[tk][dt] = __builtin_amdgcn_mfma_f32_16x16x32_bf16(va, pb, O[tk][dt], 0, 0, 0); }
                    if (tk == 1) __builtin_amdgcn_sched_barrier(0);
                }
            }
        }
#pragma unroll
        for (int tk = 0; tk < 4; ++tk) {
            float lt = l[tk]; lt += __shfl_xor(lt, 16); lt += __shfl_xor(lt, 32);
            const float inv = 1.0f / lt;
            bf16_t* yp = Y + (size_t)(tokb + r * 64 + 16 * tk + fr) * 1024 + h * 64 + 4 * fq;
#pragma unroll
            for (int dt = 0; dt < 4; ++dt) { u32x2 w; w.x = pk2(O[tk][dt][0] * inv, O[tk][dt][1] * inv); w.y = pk2(O[tk][dt][2] * inv, O[tk][dt][3] * inv); *(u32x2*)(yp + 16 * dt) = w; }
        }
        asm volatile("s_waitcnt vmcnt(0) lgkmcnt(0)" ::: "memory");
        __builtin_amdgcn_s_barrier();
#undef NA_ISSUE
    }
}

#define XB_TMO      128
#define XB_XCNT(j)  (256  + 64 * (j))
#define XB_XSUB(j)  (1280 + 64 * (j))
#define XB_XGEN(j)  (2304 + 64 * (j))
#define XB_TOP      3328
#define XB_TOPGEN   3392
#define XCD_BAR_WORDS 3456
#define XB_SPIN_CAP (1u << 22)
__device__ __forceinline__ unsigned xb_ld(unsigned* p)              { return __hip_atomic_load(p, __ATOMIC_RELAXED, __HIP_MEMORY_SCOPE_AGENT); }
__device__ __forceinline__ unsigned xb_add(unsigned* p, unsigned v) { return __hip_atomic_fetch_add(p, v, __ATOMIC_RELAXED, __HIP_MEMORY_SCOPE_AGENT); }
__device__ __forceinline__ unsigned xb_xcc_id() { return (unsigned)__builtin_amdgcn_s_getreg((3 << 11) | 20) & 0xFu; }
#define XB_SPIN(cond, bar) do { unsigned _sp = 0; while (cond) { __builtin_amdgcn_s_sleep(1); \
    if ((++_sp & 255u) == 0u) { if (xb_ld(&(bar)[XB_TMO])) break; if (_sp > XB_SPIN_CAP) { atomicAdd(&(bar)[XB_TMO], 1u); break; } } } } while (0)
struct XcdBarrier { unsigned* bar; unsigned x; volatile LAS unsigned* st; };
__device__ __forceinline__ XcdBarrier xcd_barrier_post(unsigned* bar, volatile LAS unsigned* st) {
    XcdBarrier b; b.bar = bar; b.x = xb_xcc_id(); b.st = st;
    if (threadIdx.x == 0) (void)xb_add(&bar[XB_XCNT(b.x)], 1u);
    return b;
}
__device__ __forceinline__ void xcd_barrier_complete(unsigned* bar, unsigned x, unsigned& nloc, unsigned& nx) {
    const unsigned G = gridDim.x * gridDim.y * gridDim.z;
    unsigned sum, cnt, mine, sp = 0u;
    for (;;) {
        sum = 0u; cnt = 0u; mine = 0u;
#pragma unroll
        for (unsigned j = 0; j < 16; ++j) { const unsigned c = xb_ld(&bar[XB_XCNT(j)]); sum += c; cnt += (c > 0u) ? 1u : 0u; mine = (j == x) ? c : mine; }
        if (sum == G) break;
        __builtin_amdgcn_s_sleep(1);
        if ((++sp & 255u) == 0u) { if (xb_ld(&bar[XB_TMO])) break; if (sp > XB_SPIN_CAP) { atomicAdd(&bar[XB_TMO], 1u); break; } }
    }
    nloc = mine > 0u ? mine : 1u; nx = cnt > 0u ? cnt : 1u;
}
__device__ __forceinline__ void xcd_barrier(const XcdBarrier& b) {
    asm volatile("s_waitcnt vmcnt(0)" ::: "memory");
    __syncthreads();
    if (threadIdx.x == 0) {
        unsigned* bar = b.bar;
        __builtin_amdgcn_s_waitcnt(0);
        unsigned nloc = b.st[0], nx = b.st[1];
        if (nloc == 0u) { xcd_barrier_complete(bar, b.x, nloc, nx); b.st[0] = nloc; b.st[1] = nx; }
        const unsigned old = xb_add(&bar[XB_XSUB(b.x)], 1u);
        const unsigned gen = old / nloc;
        if (old + 1u == (gen + 1u) * nloc) {
            __builtin_amdgcn_fence(__ATOMIC_RELEASE, "agent");
            asm volatile("s_waitcnt vmcnt(0)" ::: "memory");
            const unsigned og = xb_add(&bar[XB_TOP], 1u);
            const unsigned tg = og / nx;
            if (og + 1u == (tg + 1u) * nx) xb_add(&bar[XB_TOPGEN], 1u);
            else XB_SPIN(xb_ld(&bar[XB_TOPGEN]) == tg, bar);
            __builtin_amdgcn_fence(__ATOMIC_ACQUIRE, "agent");
            xb_add(&bar[XB_XGEN(b.x)], 1u);
            asm volatile("s_waitcnt vmcnt(0)" ::: "memory");
        } else {
            XB_SPIN(xb_ld(&bar[XB_XGEN(b.x)]) == gen, bar);
            __builtin_amdgcn_fence(__ATOMIC_ACQUIRE, "agent");
            asm volatile("s_waitcnt vmcnt(0)" ::: "memory");
        }
    }
    __syncthreads();
}

typedef const Args* KArgs;
__device__ __forceinline__ KArgs kargs() { unsigned long long p = (unsigned long long)__builtin_amdgcn_kernarg_segment_ptr(); asm volatile("" : "+s"(p)); return (KArgs)(const __attribute__((address_space(4))) Args*)p; }
__global__ void __launch_bounds__(NWAVES * 64, 2) mega_fwd(Args a_unused) {
    extern __shared__ __attribute__((aligned(16))) unsigned char lds_raw[];
    cg::grid_group grid = cg::this_grid();
    LAS unsigned char* lds = (LAS unsigned char*)lds_raw;
    const int wave = __builtin_amdgcn_readfirstlane((int)threadIdx.x >> 6);
#define FRESH_LANE() ({ int t_ = threadIdx.x; asm volatile("" : "+v"(t_)); t_ & 63; })
    const int G = gridDim.x, bx = blockIdx.x;
    const int vcu = (G % 8 == 0) ? (bx % 8) * (G / 8) + bx / 8 : bx;
    const int gw = vcu * NWAVES + wave, NGW = G * NWAVES;
#define WSP(T, off) ((T*)(kargs()->ws + (off)))
#define MOD WSP(float, WS_MOD)
#define GTAB WSP(float, WS_MOD + 800 * 1024)
#define W1A WSP(bf16_t, WS_W1A)
#define WV WSP(bf16_t, WS_WV)
#define WBR WSP(bf16_t, WS_WBR)
#define WOUT WSP(bf16_t, WS_WOUT)
#define WUP WSP(bf16_t, WS_WUP)
#define WDN WSP(bf16_t, WS_WDN)
#define H WSP(bf16_t, WS_H)
#define QK WSP(bf16_t, WS_QK)
#define GATES WSP(bf16_t, WS_GATES)
#define VT WSP(bf16_t, WS_VT)
#define Y WSP(bf16_t, WS_Y)
#define MIX WSP(bf16_t, WS_MIX)
#define ACT WSP(bf16_t, WS_ACT)
#define H8 WSP(unsigned char, WS_H8)
#define WG8 WSP(unsigned char, WS_WG8)
    LAS float* scr = (LAS float*)(lds + wave * 16384);
    volatile LAS unsigned* bst = (volatile LAS unsigned*)(lds + 131072 + 64);
    if (threadIdx.x < 2) bst[threadIdx.x] = 0u;
    __syncthreads();
    (void)xcd_barrier_post(WSP(unsigned, WS_BAR), bst);
#define GRID_BAR() do { XcdBarrier b_; b_.bar = (unsigned*)(kargs()->ws + WS_BAR); b_.x = xb_xcc_id(); b_.st = (volatile LAS unsigned*)((LAS unsigned char*)lds_raw + 131072 + 64); xcd_barrier(b_); } while (0)

    if (PH_MASK & 1) {
        const int lane = FRESH_LANE();
        constexpr int I1 = 2048, I2 = 512, I3 = 512, I4 = 512, I5 = 2816, I6 = 1408, IMOD = 1536, NIT = I1 + I2 + I3 + I4 + I5 + I6 + IMOD;
        const Args a = *kargs();
        float* const MODl = MOD; float* const GTABl = GTAB; bf16_t* const W1Al = W1A; bf16_t* const WVl = WV; bf16_t* const WBRl = WBR; bf16_t* const WOUTl = WOUT; bf16_t* const WUPl = WUP; bf16_t* const WDNl = WDN; unsigned char* const WG8l = WG8;
        if (gw == 0) { GTABl[lane] = a.na_q_g[lane]; GTABl[64 + lane] = a.na_k_g[lane]; GTABl[128 + lane] = a.df_q_g[lane]; GTABl[192 + lane] = a.df_k_g[lane]; }
        for (int rep_ = 0; rep_ < ((DUP_MASK & 1) ? 2 : 1); ++rep_)
        for (int it = gw; it < NIT; it += NGW) {
            int r = it;
            if (r < IMOD) { if (rep_ == 0) mod_item(a, MODl, r % 96, r / 96, scr, lane); continue; } r -= IMOD;
            if (r < I1) { const int kb = r >> 7, db = r & 127, pn = db >> 3, q = db & 7, lc = 64 * (q & 3) + 32 * (q >> 2);
                if (pn < 8) transpose_item(a.w_in, 3072, kb * 64, (pn < 4 ? pn : pn + 2) * 256 + lc, W1Al, 1024, db * 32, scr, lane);
                else transpose_item_fp8(a.w_gate, 2048, kb * 64, (pn - 8) * 256 + lc, WG8l, 1024, (db - 64) * 32, 32.0f, scr, lane);
                continue; } r -= I1;
            if (r < I2) { const int kb = r >> 5, db = r & 31, f0 = db * 32; transpose_item(a.w_in, 3072, kb * 64, f0 < 512 ? 1024 + f0 : 2048 + f0, WVl, 1024, f0, scr, lane); continue; } r -= I2;
            if (r < I3) { const int br = r >> 8, rr = r & 255, kb = rr >> 5, db = rr & 31; transpose_item(br ? a.w_df_proj : a.w_na_proj, 1024, kb * 64, db * 32, WBRl + (size_t)br * 1024 * 512, 512, db * 32, scr, lane); continue; } r -= I3;
            if (r < I4) { const int kb = r >> 5, db = r & 31; transpose_item(a.w_out, 1024, kb * 64, db * 32, WOUTl, 1024, db * 32, scr, lane); continue; } r -= I4;
            if (r < I5) { const int kb = r / 176, db = r % 176, pn = db >> 3, q = db & 7; transpose_item(a.w_up, NUP, kb * 64, q < 4 ? pn * 128 + q * 32 : DFF + pn * 128 + (q - 4) * 32, WUPl, 1024, db * 32, scr, lane); continue; } r -= I5;
            { const int kb = r >> 5, db = r & 31; transpose_item(a.w_down, 1024, kb * 64, db * 32, WDNl, DFF, db * 32, scr, lane); }
        }
    }
    if (kargs()->ws == nullptr) grid.sync();
    GRID_BAR();
    if (DUP_MASK & 512) { for (int i_ = 0; i_ < 8; ++i_) { GRID_BAR(); } }
    for (int rep_ = 0; rep_ < ((DUP_MASK & 2) ? 2 : 1); ++rep_)
    if (PH_MASK & 2) norm_rows<true>(kargs()->x, kargs()->norm1_g, MOD, 0, 1024, H, gw, NGW, FRESH_LANE(), 0, M_TOK, H8);
    GRID_BAR();
    for (int rep_ = 0; rep_ < ((DUP_MASK & 4) ? 2 : 1); ++rep_) {
    if (DUP_MASK & 2048) {
        pg8::Sched S{256, 8, 256 * 8, G, bx, 1, (const char*)H, (const char*)W1A, (unsigned)(256 * 1024 * 2), (unsigned)(256 * 1024 * 2), 0, 0};
        pg8::EpiG1a E{QK, GATES, GTAB, kargs()->b_gate};
        pg8::gemm_phase<pg8::EpiG1a, false>(lds, 256, 1024, 1024, S, E);
    }
    if (PH_MASK & 4) {
        pg8::Sched S{256, 8, 256 * 8, G, bx, 1, (const char*)H8, (const char*)WG8, 256u * 1024u, 256u * 1024u, 0, 0};
        pg8::EpiGate E{GATES, kargs()->b_gate};
        pg8::gemm_phase<pg8::EpiGate, false, true>(lds, 512, 512, 512, S, E);
    }
    if (PH_MASK & 4) {
        pg8::Sched2 S{256, 8, 256 * 8, 4, 256, 4 * 256, G, bx, (const char*)H, (const char*)W1A, (const char*)WV, (const char*)H, (unsigned)(256 * 1024 * 2), (unsigned)(256 * 1024 * 2)};
        pg8::EpiQKV E{pg8::EpiG1a{QK, GATES, GTAB, kargs()->b_gate}, pg8::EpiPlain{VT, (size_t)M_TOK}};
        pg8::gemm_phase<pg8::EpiQKV, false, false, pg8::Sched2>(lds, 1024, 1024, 1024, S, E);
    }
    }
    GRID_BAR();
    if (PH_MASK & 8) {
        const int lane = FRESH_LANE();
        KArgs ka = kargs(); const float* lq1 = ka->lam_q1; const float* lk1 = ka->lam_k1; const float* lq2 = ka->lam_q2; const float* lk2 = ka->lam_k2; const float* subg = ka->df_subln_g;
        float lam;
        { const float p1 = wave_sum(lq1[lane] * lk1[lane]), p2 = wave_sum(lq2[lane] * lk2[lane]); lam = expf(p1) - expf(p2) + 0.2f; }
        df_block(lds, QK, VT, subg, GTAB, Y, WSP(float, WS_PARK), lam, G, vcu, wave, lane);
        na_block(lds, QK, VT, kargs()->na_rpb, GTAB, Y, G, vcu, wave, FRESH_LANE());
    }
    GRID_BAR();
    if (PH_MASK & 16) {
        pg8::Sched S{256, 4, 256 * 4, G, bx, 2, (const char*)Y, (const char*)WBR, (unsigned)(256 * 1024 * 2), (unsigned)(256 * 512 * 2), (size_t)512 * 2, (unsigned)(1024 * 512 * 2)};
        pg8::EpiBranch E{MIX, GATES};
        pg8::gemm_phase<pg8::EpiBranch, false>(lds, 512, 1024, 512, S, E);
    }
    GRID_BAR();
    if (false && G == 256) {
        const int vcu_ = (bx % 8) * (G / 8) + bx / 8;
        if (PH_MASK & 32) {
            pg8::Sched S{256, 4, 256 * 4, G, vcu_, 0, (const char*)MIX, (const char*)WOUT, (unsigned)(256 * 1024 * 2), (unsigned)(256 * 1024 * 2), 0, 0};
            pg8::EpiRes E{kargs()->x, kargs()->out, MOD + 2048};
            pg8::gemm_phase<pg8::EpiRes, false>(lds, 1024, 1024, 1024, S, E);
        }
        asm volatile("s_waitcnt vmcnt(0)" ::: "memory");
        __syncthreads();
        if (PH_MASK & 2) norm_rows(kargs()->out, kargs()->norm2_g, MOD, 3072, 4096, H, wave, NWAVES, FRESH_LANE(), vcu_ * 256, vcu_ * 256 + 256);
    } else {
    if (PH_MASK & 32) {
        pg8::Sched S{256, 4, 256 * 4, G, bx, 1, (const char*)MIX, (const char*)WOUT, (unsigned)(256 * 1024 * 2), (unsigned)(256 * 1024 * 2), 0, 0};
        pg8::EpiRes E{kargs()->x, kargs()->out, MOD + 2048};
        pg8::gemm_phase<pg8::EpiRes, false>(lds, 1024, 1024, 1024, S, E);
    }
    GRID_BAR();
    if (PH_MASK & 2) norm_rows(kargs()->out, kargs()->norm2_g, MOD, 3072, 4096, H, gw, NGW, FRESH_LANE());
    }
    GRID_BAR();
    for (int rep_ = 0; rep_ < ((DUP_MASK & 64) ? 2 : 1); ++rep_)
    if (PH_MASK & 64) {
        pg8::Sched S{265, 22, 265 * 22, G, bx, 1, (const char*)(H - 1024), (const char*)WUP, (unsigned)(248 * 1024 * 2), (unsigned)(256 * 1024 * 2), 0, 0};
        pg8::EpiUp E{ACT, kargs()->conv_w, kargs()->conv_b};
        pg8::gemm_phase<pg8::EpiUp, true>(lds, 1024, 1024, 1024, S, E);
    }
    GRID_BAR();
    if (DUP_MASK & 128) {
        pg8::Sched S{256, 4, 256 * 4, G, bx, 1, (const char*)ACT, (const char*)WDN, (unsigned)(256 * DFF * 2), (unsigned)(256 * DFF * 2), 0, 0};
        float* outp = kargs()->out; pg8::EpiRes E{outp, WSP(float, 641 * MiB), MOD + 5120};
        pg8::gemm_phase<pg8::EpiRes, false>(lds, DFF, DFF, DFF, S, E);
    }
    if (PH_MASK & 128) {
        pg8::Sched S{256, 4, 256 * 4, G, bx, 1, (const char*)ACT, (const char*)WDN, (unsigned)(256 * DFF * 2), (unsigned)(256 * DFF * 2), 0, 0};
        float* outp = kargs()->out; pg8::EpiRes E{outp, outp, MOD + 5120};
        pg8::gemm_phase<pg8::EpiRes, false>(lds, DFF, DFF, DFF, S, E);
    }
}

extern "C" void kernel_launch(void* const* d_in, const int* in_sizes, int n_in, void* d_out, int out_size, void* d_ws, size_t ws_size, hipStream_t stream) {
    static int grid = 0;
    if (grid == 0) {
        if (n_in != 26 || out_size != M_TOK * DM || ws_size < WS_END) { fprintf(stderr, "kernel_launch: unexpected shapes (n_in %d out %d ws %zu)\n", n_in, out_size, ws_size); grid = -1; return; }
        int dev = 0, cus = 0, per_cu = 0;
        hipGetDevice(&dev); hipDeviceGetAttribute(&cus, hipDeviceAttributeMultiprocessorCount, dev);
        hipFuncSetAttribute((const void*)mega_fwd, hipFuncAttributeMaxDynamicSharedMemorySize, LDS_BYTES);
        hipOccupancyMaxActiveBlocksPerMultiprocessor(&per_cu, (const void*)mega_fwd, NWAVES * 64, LDS_BYTES);
        if (per_cu < 1) per_cu = 1;
        grid = cus * 1;
        (void)hipGetLastError();
    }
    if (grid < 0) return;
    hipMemsetAsync((char*)d_ws + WS_MOD, 0, 1 * MiB, stream);
    Args a{};
    const float** ap = (const float**)&a;
    for (int i = 0; i < 26; ++i) ap[i] = (const float*)d_in[i];
    a.out = (float*)d_out; a.ws = (unsigned char*)d_ws;
    void* args[] = {&a};
    hipError_t e = hipLaunchCooperativeKernel((const void*)mega_fwd, dim3(grid), dim3(NWAVES * 64), args, LDS_BYTES, stream);
    if (e != hipSuccess) fprintf(stderr, "cooperative launch failed: %s (grid %d)\n", hipGetErrorString(e), grid);
}
```

```cpp
#include <hip/hip_runtime.h>
#include <hip/hip_cooperative_groups.h>
#include <cstdio>
#include <cstdint>
namespace cg = cooperative_groups;
#ifndef PH_MASK
#define PH_MASK 0xff
#endif
#ifndef DUP_MASK
#define DUP_MASK 0
#endif

#define LAS __attribute__((address_space(3)))
typedef unsigned short bf16_t;
typedef short bf16x8 __attribute__((ext_vector_type(8)));
typedef float f32x4 __attribute__((ext_vector_type(4)));
typedef float f32x16 __attribute__((ext_vector_type(16)));
typedef float f32x2 __attribute__((ext_vector_type(2)));
typedef unsigned u32x4 __attribute__((ext_vector_type(4)));
typedef unsigned u32x2 __attribute__((ext_vector_type(2)));
typedef __bf16 bf16x2_t __attribute__((ext_vector_type(2)));

constexpr int M_TOK = 65536, DM = 1024, SEQ = 2048, NBATCH = 32, DFF = 2816, NUP = 5632, NMOD = 6144;
constexpr float EPS = 1e-6f, LOG2E = 1.4426950408889634f, QSCALE = 0.125f * 1.4426950408889634f;
constexpr int NWAVES = 8;
constexpr int LDS_BYTES = 131072 + 1024;

constexpr size_t MiB = 1u << 20;
constexpr size_t WS_MOD = 0;
constexpr size_t WS_BAR = 900 * 1024;
constexpr size_t WS_W1A = 1 * MiB;
constexpr size_t WS_WV = 9 * MiB;
constexpr size_t WS_WBR = 11 * MiB;
constexpr size_t WS_WOUT = 13 * MiB;
constexpr size_t WS_WUP = 15 * MiB;
constexpr size_t WS_WDN = 26 * MiB;
constexpr size_t WS_H = 32 * MiB + 4096;
constexpr size_t WS_QK = 161 * MiB;
constexpr size_t WS_GATES = 417 * MiB;
constexpr size_t WS_VT = 673 * MiB;
constexpr size_t WS_Y = 801 * MiB;
constexpr size_t WS_MIX = 161 * MiB;
constexpr size_t WS_ACT = 289 * MiB;
constexpr size_t WS_PARK = 929 * MiB;
constexpr size_t WS_H8 = 801 * MiB;
constexpr size_t WS_WG8 = 961 * MiB;
constexpr size_t WS_END = 963 * MiB;

struct Args {
    const float *x, *c, *ada_w, *ada_b, *norm1_g, *w_in, *na_q_g, *na_k_g, *na_rpb, *df_q_g, *df_k_g, *lam_q1, *lam_k1, *lam_q2, *lam_k2, *df_subln_g,
        *w_na_proj, *w_df_proj, *w_gate, *b_gate, *w_out, *norm2_g, *w_up, *conv_w, *conv_b, *w_down;
    float* out; unsigned char* ws;
};

__device__ __forceinline__ unsigned pk2(float lo, float hi) { f32x2 v = {lo, hi}; bf16x2_t b = __builtin_convertvector(v, bf16x2_t); return __builtin_bit_cast(unsigned, b); }
__device__ __forceinline__ float bf_lo(unsigned u) { return __uint_as_float(u << 16); }
__device__ __forceinline__ float bf_hi(unsigned u) { return __uint_as_float(u & 0xffff0000u); }
__device__ __forceinline__ float wave_sum(float v) {
#pragma unroll
    for (int o = 1; o < 64; o <<= 1) v += __shfl_xor(v, o);
    return v;
}
__device__ __forceinline__ f32x2 gelu_pk(f32x2 v) {
    const f32x2 av = __builtin_elementwise_abs(v), d = av * 0.2316418882f + 1.0f;
    f32x2 t; t.x = __builtin_amdgcn_rcpf(d.x); t.y = __builtin_amdgcn_rcpf(d.y);
    f32x2 q = t * 0.5307027145f + (-0.7265760135f); q = q * t + 0.7107068705f; q = q * t + (-0.142248368f); q = q * t + 0.127414796f; q = q * t;
    const f32x2 s = (v * v) * (-0.72134752044f);
    f32x2 e; e.x = __builtin_amdgcn_exp2f(s.x); e.y = __builtin_amdgcn_exp2f(s.y);
    const f32x2 m = v * (q * e), r = v - m;
    f32x2 o; o.x = v.x < 0.f ? m.x : r.x; o.y = v.y < 0.f ? m.y : r.y; return o;
}
__device__ __forceinline__ float dpp_rr1(float v) { return __int_as_float(__builtin_amdgcn_update_dpp(0, __float_as_int(v), 0x121, 0xF, 0xF, false)); }
__device__ __forceinline__ float dpp_rr15(float v) { return __int_as_float(__builtin_amdgcn_update_dpp(0, __float_as_int(v), 0x12F, 0xF, 0xF, false)); }
__device__ __forceinline__ float dpp_shr1(float old, float v) { return __int_as_float(__builtin_amdgcn_update_dpp(__float_as_int(old), __float_as_int(v), 0x111, 0xF, 0xF, false)); }
__device__ __forceinline__ float dpp_shl1(float old, float v) { return __int_as_float(__builtin_amdgcn_update_dpp(__float_as_int(old), __float_as_int(v), 0x101, 0xF, 0xF, false)); }
__device__ __forceinline__ float bperm(float v, int byteaddr) { return __int_as_float(__builtin_amdgcn_ds_bpermute(byteaddr, __float_as_int(v))); }
__device__ __forceinline__ float sigmoidf_(float x) { return __builtin_amdgcn_rcpf(1.0f + __builtin_amdgcn_exp2f(-x * LOG2E)); }

namespace pg8 {
constexpr int BM = 256, BK = 64, HALF = 128, HTB = HALF * BK * 2, STAGE_BYTES = 8 * HTB, NXCD = 8, WGM = 8;
__device__ __forceinline__ int lds_byte(int r, int c) { const int st = (r >> 4) * 2 + (c >> 5), rr = r & 15, cc = c & 31, ob = rr * 64 + cc * 2; return st * 1024 + (ob ^ (((ob >> 9) & 1) << 5)); }
__device__ __forceinline__ void stage_rc(int b, int& R, int& C) { const int st = b / 1024, sb = b % 1024, swz = sb ^ (((sb >> 9) & 1) << 5); R = (st >> 1) * 16 + swz / 64; C = (st & 1) * 32 + (swz % 64) / 2; }
__device__ __forceinline__ int perm32(int rho) { const int n = rho >> 4, i = rho & 15; return 8 * (i >> 2) + 4 * n + (i & 3); }

typedef int v8i_t __attribute__((ext_vector_type(8)));
typedef int v4i_t __attribute__((ext_vector_type(4)));
__device__ __forceinline__ v8i_t cat8(bf16x8 lo, bf16x8 hi) { const v4i_t a = __builtin_bit_cast(v4i_t, lo), b = __builtin_bit_cast(v4i_t, hi); return __builtin_shufflevector(a, b, 0, 1, 2, 3, 4, 5, 6, 7); }

struct Unit { int pm, pn, br; };

struct Sched {
    int nM, nN, nwg, G, c, pairs;
    const char* A; const char* B; unsigned a_tile, b_tile, a_br, b_br;
    __device__ __forceinline__ bool next(int i, Unit& u) const {
        int ii = i; u.br = 0; if (pairs == 0) { if (i >= nN || c >= nM) return false; u.pm = c; u.pn = i; return true; }
        if (pairs == 2) { ii = i >> 1; u.br = i & 1; }
        const long L = (long)ii * G + c; if (L >= nwg) return false;
        int wgid = (int)L; { const int q = nwg / NXCD, r = nwg % NXCD, xcd = wgid % NXCD, off = wgid / NXCD; wgid = (xcd < r ? xcd * (q + 1) : r * (q + 1) + (xcd - r) * q) + off; }
        const int nig = WGM * nN, gid = wgid / nig, fm = gid * WGM, gsz = (nM - fm) < WGM ? (nM - fm) : WGM;
        u.pm = fm + ((wgid % nig) % gsz); u.pn = (wgid % nig) / gsz; return true;
    }
    __device__ __forceinline__ const char* a_ptr(const Unit& u) const { return A + (size_t)u.pm * a_tile + (size_t)u.br * a_br; }
    __device__ __forceinline__ const char* b_ptr(const Unit& u) const { return B + (size_t)u.pn * b_tile + (size_t)u.br * b_br; }
};

struct Sched2 {
    int nM0, nN0, nwg0, nM1, nN1, nwg1, G, c;
    const char *A0, *B0, *A1, *B1; unsigned a_tile, b_tile;
    static __device__ __forceinline__ void map(int L, int nM, int nN, int nwg, Unit& u) {
        int wgid = L; { const int q = nwg / NXCD, r = nwg % NXCD, xcd = wgid % NXCD, off = wgid / NXCD; wgid = (xcd < r ? xcd * (q + 1) : r * (q + 1) + (xcd - r) * q) + off; }
        const int nig = WGM * nN, gid = wgid / nig, fm = gid * WGM, gsz = (nM - fm) < WGM ? (nM - fm) : WGM;
        u.pm = fm + ((wgid % nig) % gsz); u.pn = (wgid % nig) / gsz;
    }
    __device__ __forceinline__ bool next(int i, Unit& u) const {
        const long L = (long)i * G + c;
        if (L < nwg0) { u.br = 0; map((int)L, nM0, nN0, nwg0, u); return true; }
        if (L - nwg0 < nwg1) { u.br = 1; map((int)(L - nwg0), nM1, nN1, nwg1, u); return true; }
        return false;
    }
    __device__ __forceinline__ const char* a_ptr(const Unit& u) const { return (u.br ? A1 : A0) + (size_t)u.pm * a_tile; }
    __device__ __forceinline__ const char* b_ptr(const Unit& u) const { return (u.br ? B1 : B0) + (size_t)u.pn * b_tile; }
};

template <class Epi, bool STRIPS, bool FP8 = false, class SchedT = Sched>
__device__ __forceinline__ void gemm_phase(LAS unsigned char* lds, const int K, const int lda, const int ldb, const SchedT& S, const Epi& E) {
    int tid_ = threadIdx.x; asm volatile("" : "+v"(tid_));
    const int tid = tid_, wid = __builtin_amdgcn_readfirstlane(tid >> 6), lane = tid & 63, wr = wid >> 2, wc = wid & 3, fr = lane & 15, fq = lane >> 4;
    const int nt = K / BK;
    unsigned voffA, voffB;
    { int R, C; stage_rc(tid * 16, R, C); const int Rb = Epi::PERM ? ((R & ~31) + perm32(R & 31)) : R;
        const int Ra = R;
        voffA = (unsigned)(Ra * lda + C) * 2u; voffB = (unsigned)(Rb * ldb + C) * 2u; }
    const size_t pstep_voffA = (size_t)(STRIPS ? 62 : 64) * lda * 2, pstep_voffB = (size_t)64 * ldb * 2;
    const size_t kstep = (size_t)(BK * 2);
    const size_t hstepA = (size_t)(STRIPS ? 124 : 128) * lda * 2, hstepB = (size_t)HALF * ldb * 2;
    const unsigned ldsw = (unsigned)wid * 1024u;
    const int aoff = lds_byte(wr * 64 + fr, fq * 8), boff = lds_byte(wc * 32 + fr, fq * 8);
#define PG8_SA(b, h) (((b) * 2 + (h)) * HTB)
#define PG8_SB(b, h) ((4 + (b) * 2 + (h)) * HTB)
#define PG8_STAGE(bufoff, gbase, voff) do { _Pragma("unroll") for (int _i = 0; _i < 2; ++_i) \
        __builtin_amdgcn_global_load_lds((const unsigned*)((const char*)(gbase) + _i * pstep_##voff + (voff)), (LAS unsigned*)(lds + (bufoff) + ldsw + _i * 8192), 16, 0, 0); } while (0)
#define PG8_LDA(dst, b, h) do { _Pragma("unroll") for (int m = 0; m < 4; ++m) _Pragma("unroll") for (int k = 0; k < 2; ++k) dst[m][k] = *(const LAS bf16x8*)(lds + PG8_SA(b, h) + aoff + m * 2048 + k * 1024); } while (0)
#define PG8_LDB(dst, b, h) do { _Pragma("unroll") for (int n = 0; n < 2; ++n) _Pragma("unroll") for (int k = 0; k < 2; ++k) dst[n][k] = *(const LAS bf16x8*)(lds + PG8_SB(b, h) + boff + n * 2048 + k * 1024); } while (0)
#define PG8_MMA(ai, bj, At, Bt) do { __builtin_amdgcn_s_setprio(1); \
        if constexpr (FP8) {   \
            _Pragma("unroll") for (int m = 0; m < 4; ++m) _Pragma("unroll") for (int n = 0; n < 2; ++n) \
                acc[ai][bj][m][n] = __builtin_amdgcn_mfma_scale_f32_16x16x128_f8f6f4(cat8(Bt[n][0], Bt[n][1]), cat8(At[m][0], At[m][1]), acc[ai][bj][m][n], 0, 0, 0, 0, 0, 0);   \
        } else { \
            _Pragma("unroll") for (int m = 0; m < 4; ++m) _Pragma("unroll") for (int n = 0; n < 2; ++n) _Pragma("unroll") for (int k = 0; k < 2; ++k) \
                acc[ai][bj][m][n] = __builtin_amdgcn_mfma_f32_16x16x32_bf16(Bt[n][k], At[m][k], acc[ai][bj][m][n], 0, 0, 0); \
        } __builtin_amdgcn_s_setprio(0); } while (0)
#define PG8_WAIT_V(n) asm volatile("s_waitcnt vmcnt(" #n ")" ::: "memory")
#define PG8_WAIT_L(n) asm volatile("s_waitcnt lgkmcnt(" #n ")" ::: "memory")
#define PG8_BAR __builtin_amdgcn_s_barrier()
#define PG8_SCHED __builtin_amdgcn_sched_barrier(0)
    Unit cur, nxt; int ui = 0;
    if (!S.next(0, cur)) return;
    f32x4 acc[2][2][4][2];
#pragma unroll
    for (int a = 0; a < 2; ++a)
#pragma unroll
        for (int b = 0; b < 2; ++b)
#pragma unroll
            for (int m = 0; m < 4; ++m)
#pragma unroll
                for (int n = 0; n < 2; ++n) acc[a][b][m][n] = (f32x4){0.f, 0.f, 0.f, 0.f};
    bf16x8 At[4][2], B0[2][2], B1[2][2];
    const char* cA = S.a_ptr(cur); const char* cB = S.b_ptr(cur);
    PG8_STAGE(PG8_SB(0, 0), cB, voffB); PG8_STAGE(PG8_SB(0, 1), cB + hstepB, voffB); PG8_STAGE(PG8_SA(0, 0), cA, voffA); PG8_STAGE(PG8_SA(0, 1), cA + hstepA, voffA);
    if (wr == 1) PG8_BAR;
    PG8_WAIT_V(2); PG8_BAR;
    PG8_STAGE(PG8_SB(1, 0), cB + kstep, voffB); PG8_STAGE(PG8_SA(1, 0), cA + kstep, voffA); PG8_STAGE(PG8_SB(1, 1), cB + hstepB + kstep, voffB);
    PG8_WAIT_V(6); PG8_BAR;
    for (;;) {
        const bool has_next = S.next(ui + 1, nxt);
        const char* nA = has_next ? S.a_ptr(nxt) : cA; const char* nB = has_next ? S.b_ptr(nxt) : cB;
#pragma unroll 1
        for (int t = 0; t < nt; t += 2) {
            const bool last = (t == nt - 2);
            const char* a1 = cA + (size_t)(t + 1) * kstep;
            const char* a2 = last ? nA : cA + (size_t)(t + 2) * kstep; const char* b2 = last ? nB : cB + (size_t)(t + 2) * kstep;
            const char* a3 = a2 + kstep; const char* b3 = b2 + kstep;
            PG8_LDB(B0, 0, 0); PG8_LDB(B1, 0, 1); PG8_SCHED; PG8_LDA(At, 0, 0); PG8_STAGE(PG8_SA(1, 1), a1 + hstepA, voffA);
            PG8_WAIT_V(8); PG8_WAIT_L(0); PG8_BAR; PG8_MMA(0, 0, At, B0); PG8_MMA(0, 1, At, B1); PG8_BAR; PG8_SCHED;
            PG8_LDA(At, 0, 1); PG8_STAGE(PG8_SB(0, 0), b2, voffB); PG8_STAGE(PG8_SB(0, 1), b2 + hstepB, voffB); PG8_STAGE(PG8_SA(0, 0), a2, voffA);
            PG8_WAIT_V(8); PG8_WAIT_L(0); PG8_BAR; PG8_MMA(1, 0, At, B0); PG8_MMA(1, 1, At, B1); PG8_BAR; PG8_SCHED;
            PG8_LDB(B0, 1, 0); PG8_LDB(B1, 1, 1); PG8_SCHED; PG8_LDA(At, 1, 0); PG8_STAGE(PG8_SA(0, 1), a2 + hstepA, voffA);
            PG8_WAIT_V(8); PG8_WAIT_L(0); PG8_BAR; PG8_MMA(0, 0, At, B0); PG8_MMA(0, 1, At, B1); PG8_BAR; PG8_SCHED;
            PG8_LDA(At, 1, 1); PG8_STAGE(PG8_SB(1, 0), b3, voffB); PG8_STAGE(PG8_SB(1, 1), b3 + hstepB, voffB); PG8_STAGE(PG8_SA(1, 0), a3, voffA);
            PG8_WAIT_V(8); PG8_WAIT_L(0); PG8_BAR; PG8_MMA(1, 0, At, B0); PG8_MMA(1, 1, At, B1); PG8_BAR; PG8_SCHED;
        }
        if (wr == 0) PG8_BAR;
        { int te_ = threadIdx.x; asm volatile("" : "+v"(te_));
          E(acc, cur, wr, wc, te_ & 15, (te_ >> 4) & 3); }
        if (!has_next) break;
        if (!(Epi::CARRY && cur.br == 0)) {
#pragma unroll
        for (int a = 0; a < 2; ++a)
#pragma unroll
            for (int b = 0; b < 2; ++b)
#pragma unroll
                for (int m = 0; m < 4; ++m)
#pragma unroll
                    for (int n = 0; n < 2; ++n) acc[a][b][m][n] = (f32x4){0.f, 0.f, 0.f, 0.f};
        }
        cur = nxt; cA = nA; cB = nB; ++ui;
        if (wr == 1) PG8_BAR;
    }
    PG8_WAIT_V(0);
    PG8_BAR;
#undef PG8_SA
#undef PG8_SB
#undef PG8_STAGE
#undef PG8_LDA
#undef PG8_LDB
#undef PG8_MMA
#undef PG8_WAIT_V
#undef PG8_WAIT_L
#undef PG8_BAR
#undef PG8_SCHED
}

typedef const f32x4 (&AccRef)[2][2][4][2];

struct EpiG1a {
    static constexpr bool PERM = true, CARRY = false;
    bf16_t* QK; bf16_t* GATES; const float* gtab; const float* b_gate;
    __device__ __forceinline__ void operator()(AccRef acc, const Unit& u, int wr, int wc, int fr, int fq) const {
        const int row0 = u.pm * BM + wr * 64 + fr;
        if (u.pn < 8) {
            const int region = u.pn >> 1; const float* g = gtab + region * 64;
            const float qs = (region == 0 || region == 2) ? QSCALE : 1.0f;
            const f32x4 gv00 = *(const f32x4*)(g + 8 * fq) * qs, gv01 = *(const f32x4*)(g + 8 * fq + 4) * qs, gv10 = *(const f32x4*)(g + 32 + 8 * fq) * qs, gv11 = *(const f32x4*)(g + 32 + 8 * fq + 4) * qs;
            const int col0 = u.pn * 256 + 64 * wc + 8 * fq;
#pragma unroll
            for (int ai = 0; ai < 2; ++ai)
#pragma unroll
                for (int m = 0; m < 4; ++m) {
                    float ss = 0.f;
#pragma unroll
                    for (int bj = 0; bj < 2; ++bj)
#pragma unroll
                        for (int n = 0; n < 2; ++n) { const f32x4 v = acc[ai][bj][m][n]; ss += (v[0] * v[0] + v[1] * v[1]) + (v[2] * v[2] + v[3] * v[3]); }
                    ss += __shfl_xor(ss, 16); ss += __shfl_xor(ss, 32);
                    const float rstd = rsqrtf(ss * (1.0f / 64.0f) + EPS);
                    bf16_t* rowp = QK + (size_t)(row0 + ai * HALF + m * 16) * 2048 + col0;
#pragma unroll
                    for (int bj = 0; bj < 2; ++bj) { const f32x4 v0 = acc[ai][bj][m][0] * rstd * (bj ? gv10 : gv00), v1 = acc[ai][bj][m][1] * rstd * (bj ? gv11 : gv01);
                        u32x4 w; w.x = pk2(v0[0], v0[1]); w.y = pk2(v0[2], v0[3]); w.z = pk2(v1[0], v1[1]); w.w = pk2(v1[2], v1[3]);
                        *(u32x4*)(rowp + 32 * bj) = w; }
                }
        } else {
            const int col0 = (u.pn - 8) * 256 + 64 * wc + 8 * fq;
            const f32x4 bv00 = *(const f32x4*)(b_gate + col0), bv01 = *(const f32x4*)(b_gate + col0 + 4), bv10 = *(const f32x4*)(b_gate + col0 + 32), bv11 = *(const f32x4*)(b_gate + col0 + 36);
#pragma unroll
            for (int ai = 0; ai < 2; ++ai)
#pragma unroll
                for (int m = 0; m < 4; ++m) { bf16_t* rowp = GATES + (size_t)(row0 + ai * HALF + m * 16) * 2048 + col0;
#pragma unroll
                    for (int bj = 0; bj < 2; ++bj) { const f32x4 v0 = acc[ai][bj][m][0] + (bj ? bv10 : bv00), v1 = acc[ai][bj][m][1] + (bj ? bv11 : bv01);
                        u32x4 w; w.x = pk2(sigmoidf_(v0[0]), sigmoidf_(v0[1])); w.y = pk2(sigmoidf_(v0[2]), sigmoidf_(v0[3]));
                        w.z = pk2(sigmoidf_(v1[0]), sigmoidf_(v1[1])); w.w = pk2(sigmoidf_(v1[2]), sigmoidf_(v1[3]));
                        *(u32x4*)(rowp + 32 * bj) = w; } }
        }
    }
};
struct EpiGate {
    static constexpr bool PERM = true, CARRY = false;
    bf16_t* GATES; const float* b_gate;
    __device__ __forceinline__ void operator()(AccRef acc, const Unit& u, int wr, int wc, int fr_in, int fq_in) const {
        int fr = fr_in, fq = fq_in; asm volatile("" : "+v"(fr), "+v"(fq));
        const int row0 = u.pm * BM + wr * 64 + fr;
        const int col0 = u.pn * 256 + 64 * wc + 8 * fq;
#pragma unroll
        for (int ai = 0; ai < 2; ++ai)
#pragma unroll
            for (int m = 0; m < 4; ++m) { bf16_t* rowp = GATES + (size_t)(row0 + ai * HALF + m * 16) * 2048 + col0;
#pragma unroll
                for (int bj = 0; bj < 2; ++bj) { const f32x4 b0 = *(const f32x4*)(b_gate + col0 + 32 * bj), b1 = *(const f32x4*)(b_gate + col0 + 32 * bj + 4);
                    const f32x4 v0 = acc[ai][bj][m][0] * 0.03125f + b0, v1 = acc[ai][bj][m][1] * 0.03125f + b1;
                    u32x4 w; w.x = pk2(sigmoidf_(v0[0]), sigmoidf_(v0[1])); w.y = pk2(sigmoidf_(v0[2]), sigmoidf_(v0[3]));
                    w.z = pk2(sigmoidf_(v1[0]), sigmoidf_(v1[1])); w.w = pk2(sigmoidf_(v1[2]), sigmoidf_(v1[3]));
                    *(u32x4*)(rowp + 32 * bj) = w; } }
    }
};
struct EpiPlain {
    static constexpr bool PERM = true, CARRY = false;
    bf16_t* O; size_t ldc;
    __device__ __forceinline__ void operator()(AccRef acc, const Unit& u, int wr, int wc, int fr, int fq) const {
        const int row0 = u.pm * BM + wr * 64 + fr, col0 = u.pn * BM + wc * 32 + 8 * fq;
#pragma unroll
        for (int ai = 0; ai < 2; ++ai)
#pragma unroll
            for (int m = 0; m < 4; ++m) { bf16_t* rowp = O + (size_t)(row0 + ai * HALF + m * 16) * ldc + col0;
#pragma unroll
                for (int bj = 0; bj < 2; ++bj) { const f32x4 v0 = acc[ai][bj][m][0], v1 = acc[ai][bj][m][1];
                    u32x4 w; w.x = pk2(v0[0], v0[1]); w.y = pk2(v0[2], v0[3]); w.z = pk2(v1[0], v1[1]); w.w = pk2(v1[2], v1[3]);
                    *(u32x4*)(rowp + bj * HALF) = w; } }
    }
};
struct EpiQKV {
    static constexpr bool PERM = true, CARRY = false;
    EpiG1a e0; EpiPlain e1;
    __device__ __forceinline__ void operator()(AccRef acc, const Unit& u, int wr, int wc, int fr, int fq) const {
        if (u.br == 0) e0(acc, u, wr, wc, fr, fq); else e1(acc, u, wr, wc, fr, fq);
    }
};
struct EpiBranch {
    static constexpr bool PERM = true, CARRY = true;
    bf16_t* MIX; const bf16_t* GATES;
    __device__ __forceinline__ void operator()(f32x4 (&acc)[2][2][4][2], const Unit& u, int wr, int wc, int fr, int fq) const {
        const int row0 = u.pm * BM + wr * 64 + fr, col0 = u.pn * BM + wc * 32 + 8 * fq;
#pragma unroll
        for (int ai = 0; ai < 2; ++ai)
#pragma unroll
            for (int m = 0; m < 4; ++m) { const size_t row = (size_t)(row0 + ai * HALF + m * 16);
#pragma unroll
                for (int bj = 0; bj < 2; ++bj) {
                    const u32x4 gb = *(const u32x4*)(GATES + row * 2048 + 1024 + col0 + bj * HALF);
                    if (u.br == 0) {
                        const u32x4 ga = *(const u32x4*)(GATES + row * 2048 + col0 + bj * HALF);
                        f32x4& a0 = acc[ai][bj][m][0]; f32x4& a1 = acc[ai][bj][m][1];
                        a0[0] *= bf_lo(ga.x) * __builtin_amdgcn_rcpf(bf_lo(gb.x)); a0[1] *= bf_hi(ga.x) * __builtin_amdgcn_rcpf(bf_hi(gb.x));
                        a0[2] *= bf_lo(ga.y) * __builtin_amdgcn_rcpf(bf_lo(gb.y)); a0[3] *= bf_hi(ga.y) * __builtin_amdgcn_rcpf(bf_hi(gb.y));
                        a1[0] *= bf_lo(ga.z) * __builtin_amdgcn_rcpf(bf_lo(gb.z)); a1[1] *= bf_hi(ga.z) * __builtin_amdgcn_rcpf(bf_hi(gb.z));
                        a1[2] *= bf_lo(ga.w) * __builtin_amdgcn_rcpf(bf_lo(gb.w)); a1[3] *= bf_hi(ga.w) * __builtin_amdgcn_rcpf(bf_hi(gb.w));
                    } else {
                        const f32x4 a0 = acc[ai][bj][m][0], a1 = acc[ai][bj][m][1];
                        u32x4 w; w.x = pk2(a0[0] * bf_lo(gb.x), a0[1] * bf_hi(gb.x)); w.y = pk2(a0[2] * bf_lo(gb.y), a0[3] * bf_hi(gb.y));
                        w.z = pk2(a1[0] * bf_lo(gb.z), a1[1] * bf_hi(gb.z)); w.w = pk2(a1[2] * bf_lo(gb.w), a1[3] * bf_hi(gb.w));
                        *(u32x4*)(MIX + row * 1024 + col0 + bj * HALF) = w;
                    }
                } }
    }
};
struct EpiRes {
    static constexpr bool PERM = false, CARRY = false;
    const float* base; float* out; const float* gmod;
    __device__ __forceinline__ void operator()(AccRef acc, const Unit& u, int wr, int wc, int fr, int fq) const {
        const int row0 = u.pm * BM + wr * 64 + fr, col0 = u.pn * BM + wc * 32 + 4 * fq;
        const float* gm = gmod + (size_t)(u.pm >> 3) * NMOD + col0;
        f32x4 gv[2][2];
#pragma unroll
        for (int bj = 0; bj < 2; ++bj)
#pragma unroll
            for (int n = 0; n < 2; ++n) gv[bj][n] = *(const f32x4*)(gm + bj * HALF + n * 16);
#pragma unroll
        for (int ai = 0; ai < 2; ++ai)
#pragma unroll
            for (int m = 0; m < 4; ++m) { const size_t off = (size_t)(row0 + ai * HALF + m * 16) * DM + col0;
#pragma unroll
                for (int bj = 0; bj < 2; ++bj)
#pragma unroll
                    for (int n = 0; n < 2; ++n) { const f32x4 bs = *(const f32x4*)(base + off + bj * HALF + n * 16);
                        *(f32x4*)(out + off + bj * HALF + n * 16) = bs + gv[bj][n] * acc[ai][bj][m][n]; } }
    }
};
struct EpiUp {
    static constexpr bool PERM = true, CARRY = false;
    bf16_t* ACT; const float* cw; const float* cb;
    __device__ __forceinline__ void operator()(AccRef acc, const Unit& u, int wr, int wc, int fr, int fq) const {
        const int lane = threadIdx.x & 63;
        const int srcL = ((lane & 48) | ((fr + 15) & 15)) * 4, srcR = ((lane & 48) | ((fr + 1) & 15)) * 4;
        const int fcol0 = u.pn * 128 + 32 * wc + 8 * fq;
#pragma unroll
        for (int n = 0; n < 2; ++n) {
            const int fc = fcol0 + 4 * n;
            const f32x4 wa0 = *(const f32x4*)(cw + fc), wa1 = *(const f32x4*)(cw + NUP + fc), wa2 = *(const f32x4*)(cw + 2 * NUP + fc), ba = *(const f32x4*)(cb + fc);
            const f32x4 wl0 = *(const f32x4*)(cw + DFF + fc), wl1 = *(const f32x4*)(cw + NUP + DFF + fc), wl2 = *(const f32x4*)(cw + 2 * NUP + DFF + fc), bl = *(const f32x4*)(cb + DFF + fc);
#pragma unroll
            for (int ai = 0; ai < 2; ++ai) {
                const int gb = u.pm * 248 + 62 * (2 * ai + wr) - 1;
#pragma unroll
                for (int m = 0; m < 4; ++m) {
                    int j = 16 * m + fr; asm volatile("" : "+v"(j));
                    const int grow = gb + j;
                    const bool hasL = (grow & 2047) != 0, hasR = (grow & 2047) != 2047;
                    f32x4 ua, ul;
                    const bool edge = __any(!(hasL && hasR));
#pragma unroll
                    for (int e = 0; e < 4; ++e) {
#pragma unroll
                        for (int bj = 0; bj < 2; ++bj) {
                            const float c = acc[ai][bj][m][n][e];
                            const float oldL = (m > 0) ? dpp_rr1(acc[ai][bj][m > 0 ? m - 1 : 0][n][e]) : 0.f;
                            const float oldR = (m < 3) ? dpp_rr15(acc[ai][bj][m < 3 ? m + 1 : 3][n][e]) : 0.f;
                            float Lv = dpp_shr1(oldL, c), Rv = dpp_shl1(oldR, c);
                            if (edge) { Lv = hasL ? Lv : 0.f; Rv = hasR ? Rv : 0.f; }
                            if (bj == 0) ua[e] = (ba[e] + wa1[e] * c) + (wa0[e] * Lv + wa2[e] * Rv);
                            else         ul[e] = (bl[e] + wl1[e] * c) + (wl0[e] * Lv + wl2[e] * Rv);
                        }
                    }
                    const f32x2 g0 = gelu_pk((f32x2){ua[0], ua[1]}), g1 = gelu_pk((f32x2){ua[2], ua[3]});
                    u32x2 w; w.x = pk2(g0.x * ul[0], g0.y * ul[1]); w.y = pk2(g1.x * ul[2], g1.y * ul[3]);
                    if (j >= 1 && j <= 62 && grow < M_TOK) *(u32x2*)(ACT + (size_t)grow * DFF + fc) = w;
                }
            }
        }
    }
};
}

#define LDS_WAIT() asm volatile("s_waitcnt lgkmcnt(0)" ::: "memory")
__device__ __forceinline__ void transpose_item(const float* W, int Nsrc, int k0, int srccol, bf16_t* WT, int Kdst, int dstrow, LAS float* scr, int lane) {
    f32x4 ld_[8];
#pragma unroll
    for (int i = 0; i < 8; ++i) ld_[i] = *(const f32x4*)(W + (size_t)(k0 + (lane >> 3) + 8 * i) * Nsrc + srccol + 4 * (lane & 7));
#pragma unroll
    for (int i = 0; i < 8; ++i) { LAS float* d_ = scr + ((lane >> 3) + 8 * i) * 33 + 4 * (lane & 7); d_[0] = ld_[i][0]; d_[1] = ld_[i][1]; d_[2] = ld_[i][2]; d_[3] = ld_[i][3]; }
    LDS_WAIT(); asm volatile("" ::: "memory");
    const int c = lane & 7;
#pragma unroll
    for (int j = 0; j < 4; ++j) { const int n = (lane >> 3) + 8 * j; const LAS float* s = scr + (8 * c) * 33 + n;
        u32x4 o; o.x = pk2(s[0 * 33], s[1 * 33]); o.y = pk2(s[2 * 33], s[3 * 33]); o.z = pk2(s[4 * 33], s[5 * 33]); o.w = pk2(s[6 * 33], s[7 * 33]);
        *(u32x4*)(WT + (size_t)(dstrow + n) * Kdst + k0 + 8 * c) = o; }
    LDS_WAIT(); asm volatile("" ::: "memory");
}
__device__ __forceinline__ unsigned pk4_fp8(float a, float b, float c, float d) { int p = __builtin_amdgcn_cvt_pk_fp8_f32(a, b, 0, false); p = __builtin_amdgcn_cvt_pk_fp8_f32(c, d, p, true); return (unsigned)p; }
__device__ __forceinline__ void transpose_item_fp8(const float* W, int Nsrc, int k0, int srccol, unsigned char* WT8, int Kdst, int dstrow, float scale, LAS float* scr, int lane) {
    f32x4 ld_[8];
#pragma unroll
    for (int i = 0; i < 8; ++i) ld_[i] = *(const f32x4*)(W + (size_t)(k0 + (lane >> 3) + 8 * i) * Nsrc + srccol + 4 * (lane & 7));
#pragma unroll
    for (int i = 0; i < 8; ++i) { LAS float* d_ = scr + ((lane >> 3) + 8 * i) * 33 + 4 * (lane & 7); d_[0] = ld_[i][0] * scale; d_[1] = ld_[i][1] * scale; d_[2] = ld_[i][2] * scale; d_[3] = ld_[i][3] * scale; }
    LDS_WAIT(); asm volatile("" ::: "memory");
    const int c = lane & 7;
#pragma unroll
    for (int j = 0; j < 4; ++j) { const int n = (lane >> 3) + 8 * j; const LAS float* s = scr + (8 * c) * 33 + n;
        u32x2 o; o.x = pk4_fp8(s[0 * 33], s[1 * 33], s[2 * 33], s[3 * 33]); o.y = pk4_fp8(s[4 * 33], s[5 * 33], s[6 * 33], s[7 * 33]);
        *(u32x2*)(WT8 + (size_t)(dstrow + n) * Kdst + k0 + 8 * c) = o; }
    LDS_WAIT(); asm volatile("" ::: "memory");
}
__device__ __forceinline__ void mod_item(const Args& a, float* mod, int nb, int kc, LAS float* scr, int lane) {
    const int n0 = nb * 64, k0 = kc * 64;
#pragma unroll 4
    for (int b = 0; b < 32; ++b) { const float v = a.c[b * DM + k0 + lane]; scr[lane * 32 + b] = v * sigmoidf_(v); }
    LDS_WAIT(); asm volatile("" ::: "memory");
    float acc[32];
#pragma unroll
    for (int b = 0; b < 32; ++b) acc[b] = 0.f;
#pragma unroll 4
    for (int k = 0; k < 64; ++k) {
        const float w = a.ada_w[(size_t)(k0 + k) * NMOD + n0 + lane];
#pragma unroll
        for (int b4 = 0; b4 < 8; ++b4) { const f32x4 cv = *(const LAS f32x4*)(scr + k * 32 + 4 * b4);
            acc[4 * b4 + 0] += cv[0] * w; acc[4 * b4 + 1] += cv[1] * w; acc[4 * b4 + 2] += cv[2] * w; acc[4 * b4 + 3] += cv[3] * w; }
    }
    const float bias = (kc == 0) ? a.ada_b[n0 + lane] : 0.f;
#pragma unroll
    for (int b = 0; b < 32; ++b) atomicAdd(mod + (size_t)b * NMOD + n0 + lane, acc[b] + bias);
    LDS_WAIT(); asm volatile("" ::: "memory");
}
template <bool WITH_FP8 = false> __device__ __forceinline__ void norm_rows(const float* X, const float* gain, const float* mod, int sh_off, int sc_off, bf16_t* Hout, int gw, int NGW, int lane, int mbeg = 0, int mend = M_TOK, unsigned char* H8out = nullptr) {
    for (int m0 = mbeg + 2 * gw; m0 < mend; m0 += 2 * NGW) {
        f32x4 v[2][4]; float ss[2];
#pragma unroll
        for (int q = 0; q < 2; ++q) { const f32x4* xr = (const f32x4*)(X + (size_t)(m0 + q) * DM) + lane;
#pragma unroll
            for (int j = 0; j < 4; ++j) v[q][j] = xr[64 * j]; }
#pragma unroll
        for (int q = 0; q < 2; ++q) { float s_ = 0.f;
#pragma unroll
            for (int j = 0; j < 4; ++j) s_ += (v[q][j][0] * v[q][j][0] + v[q][j][1] * v[q][j][1]) + (v[q][j][2] * v[q][j][2] + v[q][j][3] * v[q][j][3]);
            ss[q] = rsqrtf(wave_sum(s_) * (1.0f / DM) + EPS); }
        const float* mb = mod + (size_t)(m0 >> 11) * NMOD;
#pragma unroll
        for (int j = 0; j < 4; ++j) { const int col = 4 * lane + 256 * j;
            const f32x4 g = *(const f32x4*)(gain + col), sc = *(const f32x4*)(mb + sc_off + col) + 1.0f, sh = *(const f32x4*)(mb + sh_off + col);
            const f32x4 gs = g * sc;
#pragma unroll
            for (int q = 0; q < 2; ++q) { const f32x4 y = v[q][j] * ss[q] * gs + sh;
                u32x2 w; w.x = pk2(y[0], y[1]); w.y = pk2(y[2], y[3]); ((u32x2*)(Hout + (size_t)(m0 + q) * DM) + lane)[64 * j] = w;
                if constexpr (WITH_FP8) ((unsigned*)(H8out + (size_t)(m0 + q) * DM) + lane)[64 * j] = pk4_fp8(y[0], y[1], y[2], y[3]); } }
    }
}

__device__ __forceinline__ bf16x8 ld16(const bf16_t* p) { return *(const bf16x8*)p; }
__device__ __forceinline__ bf16x8 pack8(float a0, float a1, float a2, float a3, float a4, float a5, float a6, float a7) {
    u32x4 w; w.x = pk2(a0, a1); w.y = pk2(a2, a3); w.z = pk2(a4, a5); w.w = pk2(a6, a7); return __builtin_bit_cast(bf16x8, w);
}
__device__ __forceinline__ void na_unit(const bf16_t* QK, const bf16_t* VT, const float* rpb, bf16_t* Y, int b, int h, int r, int cgp, int lane) {
    const int fr = lane & 15, fq = lane >> 4;
    int r0 = r - 4; r0 = r0 < 0 ? 0 : (r0 > 24 ? 24 : r0);
    const int c0 = 16 * cgp, w0 = (cgp == 0) ? 0 : (cgp == 1) ? 8 : (cgp == 2) ? 24 : 32;
    const int tokb = b * SEQ;
    const int qrow = tokb + r * 64 + c0 + fr;
    bf16x8 qf[2];
#pragma unroll
    for (int ks = 0; ks < 2; ++ks) qf[ks] = ld16(QK + (size_t)qrow * 2048 + h * 64 + 32 * ks + 8 * fq);
    f32x4 s[8][2];
#pragma unroll
    for (int i = 0; i < 8; ++i)
#pragma unroll
        for (int t = 0; t < 2; ++t) {
            const int kcolA = w0 + 8 * (fr >> 2) + 4 * t + (fr & 3);
            const bf16_t* kp = QK + (size_t)(tokb + (r0 + i) * 64 + kcolA) * 2048 + 512 + h * 64 + 8 * fq;
            const bf16x8 a0 = ld16(kp), a1 = ld16(kp + 32);
            f32x4 acc = {0.f, 0.f, 0.f, 0.f};
            acc = __builtin_amdgcn_mfma_f32_16x16x32_bf16(a0, qf[0], acc, 0, 0, 0);
            acc = __builtin_amdgcn_mfma_f32_16x16x32_bf16(a1, qf[1], acc, 0, 0, 0);
            s[i][t] = acc;
        }
    const int qc = c0 + fr; int cs = qc - 8; cs = cs < 0 ? 0 : (cs > 48 ? 48 : cs);
    float mx = -1e30f;
#pragma unroll
    for (int i = 0; i < 8; ++i) {
        const float* bp = rpb + (size_t)(h * 15 + (r0 + i - r + 7)) * 31;
#pragma unroll
        for (int t = 0; t < 2; ++t)
#pragma unroll
            for (int j = 0; j < 4; ++j) {
                const int kcol = w0 + 8 * fq + 4 * t + j;
                const bool valid = (kcol >= cs) && (kcol < cs + 16);
                int dc = kcol - qc + 15; dc = dc < 0 ? 0 : (dc > 30 ? 30 : dc);
                const float v = valid ? (s[i][t][j] + bp[dc] * LOG2E) : -1e30f;
                s[i][t][j] = v; mx = fmaxf(mx, v);
            }
    }
    mx = fmaxf(mx, __shfl_xor(mx, 16)); mx = fmaxf(mx, __shfl_xor(mx, 32));
    float sum = 0.f;
#pragma unroll
    for (int i = 0; i < 8; ++i)
#pragma unroll
        for (int t = 0; t < 2; ++t)
#pragma unroll
            for (int j = 0; j < 4; ++j) { const float p = __builtin_amdgcn_exp2f(s[i][t][j] - mx); s[i][t][j] = p; sum += p; }
    sum += __shfl_xor(sum, 16); sum += __shfl_xor(sum, 32);
    const float inv = 1.0f / sum;
    f32x4 o[4];
#pragma unroll
    for (int dt = 0; dt < 4; ++dt) o[dt] = (f32x4){0.f, 0.f, 0.f, 0.f};
#pragma unroll
    for (int i = 0; i < 8; ++i) {
        const bf16x8 pb = pack8(s[i][0][0], s[i][0][1], s[i][0][2], s[i][0][3], s[i][1][0], s[i][1][1], s[i][1][2], s[i][1][3]);
        const bf16_t* vp = VT + (size_t)(h * 64 + fr) * M_TOK + tokb + (r0 + i) * 64 + w0 + 8 * fq;
#pragma unroll
        for (int dt = 0; dt < 4; ++dt) { const bf16x8 va = ld16(vp + (size_t)(16 * dt) * M_TOK);
            o[dt] = __builtin_amdgcn_mfma_f32_16x16x32_bf16(va, pb, o[dt], 0, 0, 0); }
    }
    bf16_t* yp = Y + (size_t)qrow * 1024 + h * 64 + 4 * fq;
#pragma unroll
    for (int dt = 0; dt < 4; ++dt) { u32x2 w; w.x = pk2(o[dt][0] * inv, o[dt][1] * inv); w.y = pk2(o[dt][2] * inv, o[dt][3] * inv); *(u32x2*)(yp + 16 * dt) = w; }
}

__device__ __forceinline__ void df_unit(const bf16_t* QK, const bf16_t* VT, const float* subg, bf16_t* Y, int b, int h, int qb, float lam, LAS float* park, int lane) {
    const int r32 = lane & 31, hi = lane >> 5;
    const int q0 = qb * 32, tokb = b * SEQ;
    const float slope2 = __builtin_amdgcn_exp2f(-2.0f * (float)(h + 1)) * LOG2E;
    const int phi = (r32 & 19) | ((r32 & 4) << 1) | ((r32 & 8) >> 1);
    f32x16 O[4];
#pragma unroll 1
    for (int c = 0; c < 2; ++c) {
        bf16x8 qf[4];
#pragma unroll
        for (int d0 = 0; d0 < 4; ++d0) qf[d0] = ld16(QK + (size_t)(tokb + q0 + r32) * 2048 + 1024 + h * 128 + c * 64 + 16 * d0 + 8 * hi);
#pragma unroll
        for (int d = 0; d < 4; ++d)
#pragma unroll
            for (int r = 0; r < 16; ++r) O[d][r] = 0.f;
        float mrun = -1e30f, l = 0.f;
        const bf16_t* kbase = QK + (size_t)(tokb + phi) * 2048 + 1536 + h * 128 + c * 64 + 8 * hi;
        const bf16_t* vbase = VT + (size_t)(512 + h * 128 + r32) * M_TOK + tokb + 8 * hi;
#pragma unroll 1
        for (int kt = 0; kt < SEQ / 64; ++kt) {
            const int kv0 = kt * 64;
            f32x16 S[2];
#pragma unroll
            for (int sub = 0; sub < 2; ++sub) {
#pragma unroll
                for (int r = 0; r < 16; ++r) S[sub][r] = 0.f;
#pragma unroll
                for (int d0 = 0; d0 < 4; ++d0) { const bf16x8 kf = ld16(kbase + (size_t)(kv0 + 32 * sub) * 2048 + 16 * d0);
                    S[sub] = __builtin_amdgcn_mfma_f32_32x32x16_bf16(kf, qf[d0], S[sub], 0, 0, 0); }
            }
            const float base = (float)(kv0 + 8 * hi - q0 - r32);
            float mx = -1e30f;
#pragma unroll
            for (int sub = 0; sub < 2; ++sub)
#pragma unroll
                for (int r = 0; r < 16; ++r) { const float t = base + (float)(32 * sub + (r & 7) + 16 * (r >> 3));
                    const float v = S[sub][r] - slope2 * fabsf(t); S[sub][r] = v; mx = fmaxf(mx, v); }
            mx = fmaxf(mx, __shfl_xor(mx, 32));
            const float mnew = fmaxf(mrun, mx), alpha = __builtin_amdgcn_exp2f(mrun - mnew); mrun = mnew;
            float rs = 0.f;
#pragma unroll
            for (int sub = 0; sub < 2; ++sub)
#pragma unroll
                for (int r = 0; r < 16; ++r) { const float p = __builtin_amdgcn_exp2f(S[sub][r] - mnew); S[sub][r] = p; rs += p; }
            l = l * alpha + rs;
#pragma unroll
            for (int d = 0; d < 4; ++d)
#pragma unroll
                for (int r = 0; r < 16; ++r) O[d][r] *= alpha;
            bf16x8 pb[2][2];
#pragma unroll
            for (int sub = 0; sub < 2; ++sub)
#pragma unroll
                for (int sl = 0; sl < 2; ++sl) pb[sub][sl] = pack8(S[sub][8 * sl + 0], S[sub][8 * sl + 1], S[sub][8 * sl + 2], S[sub][8 * sl + 3], S[sub][8 * sl + 4], S[sub][8 * sl + 5], S[sub][8 * sl + 6], S[sub][8 * sl + 7]);
#pragma unroll
            for (int d = 0; d < 4; ++d) {
                if (d == 2) __builtin_amdgcn_sched_barrier(0);
#pragma unroll
                for (int sub = 0; sub < 2; ++sub)
#pragma unroll
                    for (int sl = 0; sl < 2; ++sl) { const bf16x8 va = ld16(vbase + (size_t)(32 * d) * M_TOK + kv0 + 32 * sub + 16 * sl);
                        O[d] = __builtin_amdgcn_mfma_f32_32x32x16_bf16(va, pb[sub][sl], O[d], 0, 0, 0); }
            }
        }
        l += __shfl_xor(l, 32);
        const float inv = 1.0f / l;
        if (c == 0) {
#pragma unroll
            for (int d = 0; d < 4; ++d)
#pragma unroll
                for (int r = 0; r < 16; ++r) park[(d * 16 + r) * 64 + lane] = O[d][r] * inv;
        } else {
            LDS_WAIT();
            float ss = 0.f;
#pragma unroll
            for (int d = 0; d < 4; ++d)
#pragma unroll
                for (int r = 0; r < 16; ++r) { const float v = park[(d * 16 + r) * 64 + lane] - lam * (O[d][r] * inv); O[d][r] = v; ss += v * v; }
            ss += __shfl_xor(ss, 32);
            const float rstd = rsqrtf(ss * (1.0f / 128.0f) + EPS) * 0.8f;
            bf16_t* yp = Y + (size_t)(tokb + q0 + r32) * 1024 + 512 + h * 128 + 4 * hi;
#pragma unroll
            for (int d = 0; d < 4; ++d)
#pragma unroll
                for (int g = 0; g < 4; ++g) { const int dcol = 32 * d + 8 * g + 4 * hi; const f32x4 sg = *(const f32x4*)(subg + dcol);
                    u32x2 w; w.x = pk2(O[d][4 * g + 0] * rstd * sg[0], O[d][4 * g + 1] * rstd * sg[1]); w.y = pk2(O[d][4 * g + 2] * rstd * sg[2], O[d][4 * g + 3] * rstd * sg[3]);
                    *(u32x2*)(yp + 32 * d + 8 * g) = w; }
            LDS_WAIT();
        }
    }
}


constexpr int DF_STAGE = 24576, DF_NST = 3;
#define DF_WAIT_V(n) asm volatile("s_waitcnt vmcnt(" #n ")" ::: "memory")
__device__ __forceinline__ void df_block(LAS unsigned char* lds, const bf16_t* QK, const bf16_t* VT, const float* subg, const float* gtab, bf16_t* Y, float* parkg, float lam, int G, int vcu, int wave, int lane) {
    const int r32 = lane & 31, hi = lane >> 5;
    const int phi = (r32 & 19) | ((r32 & 4) << 1) | ((r32 & 8) >> 1);
    float Bst;
    { float gq = fabsf(gtab[128 + lane]), gk = fabsf(gtab[192 + lane]);
#pragma unroll
      for (int o = 1; o < 64; o <<= 1) { gq = fmaxf(gq, __shfl_xor(gq, o)); gk = fmaxf(gk, __shfl_xor(gk, o)); }
      Bst = 11.6f * gq * gk + 0.5f; }
    const int prow = 8 * wave + (lane >> 3), pc = lane & 7;
    const size_t ksrc = (size_t)prow * 2048 + (size_t)((pc ^ ((prow >> 1) & 7)) * 8);
    const size_t vsrc0 = (size_t)prow * M_TOK + (size_t)((pc ^ ((prow >> 1) & 7)) * 8);
    const size_t vsrc1 = (size_t)(prow + 64) * M_TOK + (size_t)((pc ^ (((prow + 64) >> 1) & 7)) * 8);
    const int kx = (phi >> 1) & 7, vx = (r32 >> 1) & 7;
    const int koff0 = phi * 128 + ((hi ^ kx) * 16), voff0 = 8192 + r32 * 128 + ((hi ^ vx) * 16);
    float* park = parkg + (size_t)(vcu * NWAVES + wave) * 4096;
    for (int u = vcu; u < NBATCH * 4 * 8 * ((DUP_MASK & 8) ? 2 : 1); u += G) {
        const int up_ = u & 255, qblk = up_ & 7, b = up_ >> 3, h = ((u >> 8) + up_) & 3;
        const int tokb = b * SEQ, q0w = qblk * 256 + wave * 32;
        const float slope2 = __builtin_amdgcn_exp2f(-2.0f * (float)(h + 1)) * LOG2E;
        const bf16_t* Kg = QK + (size_t)tokb * 2048 + 1536 + h * 128;
        const bf16_t* Vg = VT + (size_t)(512 + h * 128) * M_TOK + tokb;
        const int kvmix = q0w & ~63;
        const float tqf = (float)(8 * hi - q0w - r32);
        const int Dk = (int)(160.0f / slope2) + 2;
        int kt_lo = (qblk * 256 - Dk - 63 + 63) >> 6; kt_lo = kt_lo < 0 ? 0 : kt_lo;
        int kt_hi = (qblk * 256 + 255 + Dk) >> 6; kt_hi = kt_hi > 31 ? 31 : kt_hi;
        const int NT = kt_hi - kt_lo + 1, NG = 2 * NT;
#define DF_ISSUE(g_) do { const int c_ = ((g_) >= NT) ? 1 : 0, kt_ = kt_lo + (g_) - c_ * NT, st_ = (g_) % DF_NST; LAS unsigned char* sb_ = lds + st_ * DF_STAGE + wave * 1024; \
            __builtin_amdgcn_global_load_lds((const unsigned*)(Kg + (size_t)kt_ * 64 * 2048 + c_ * 64 + ksrc), (LAS unsigned*)(sb_), 16, 0, 0); \
            __builtin_amdgcn_global_load_lds((const unsigned*)(Vg + kt_ * 64 + vsrc0), (LAS unsigned*)(sb_ + 8192), 16, 0, 0); \
            __builtin_amdgcn_global_load_lds((const unsigned*)(Vg + kt_ * 64 + vsrc1), (LAS unsigned*)(sb_ + 16384), 16, 0, 0); } while (0)
        DF_ISSUE(0); DF_ISSUE(1);
#pragma unroll 1
        for (int c = 0; c < 2; ++c) {
            f32x16 O[4], Dp; bf16x8 qf[4]; float l = 0.f;
#pragma unroll
            for (int d0 = 0; d0 < 4; ++d0) qf[d0] = ld16(QK + (size_t)(tokb + q0w + r32) * 2048 + 1024 + h * 128 + c * 64 + 16 * d0 + 8 * hi);
#pragma unroll
            for (int d = 0; d < 4; ++d)
#pragma unroll
                for (int r = 0; r < 16; ++r) O[d][r] = 0.f;
#pragma unroll
            for (int r = 0; r < 16; ++r) Dp[r] = slope2 * (float)((r & 7) + 16 * (r >> 3));
#pragma unroll 1
            for (int kt = kt_lo; kt <= kt_hi; ++kt) {
                const int g = c * NT + (kt - kt_lo), kv0 = kt * 64;
                if (kt == kt_lo || g == NG - 1) { DF_WAIT_V(0); } else { DF_WAIT_V(3); }
                __builtin_amdgcn_s_barrier();
                asm volatile("" ::: "memory");
                if (g + 2 < NG) DF_ISSUE(g + 2);
                LAS unsigned char* st = lds + (g % DF_NST) * DF_STAGE;
                int kb_ = koff0, vb_ = voff0; asm volatile("" : "+v"(kb_), "+v"(vb_));
                const bool mixed = (kv0 == kvmix);
                float base = (float)kv0 + tqf; asm volatile("" : "+v"(base));
                f32x2 rs2 = {0.f, 0.f};
#pragma unroll
                for (int sub = 0; sub < 2; ++sub) {
                    f32x16 S = Dp;
#pragma unroll
                    for (int d0 = 0; d0 < 4; ++d0) { const bf16x8 kf = *(const LAS bf16x8*)(st + sub * 4096 + (kb_ ^ (32 * d0)));
                        S = __builtin_amdgcn_mfma_f32_32x32x16_bf16(kf, qf[d0], S, 0, 0, 0); }
                    if (mixed) {
#pragma unroll
                        for (int r = 0; r < 16; ++r) { const float t = base + (float)(32 * sub + (r & 7) + 16 * (r >> 3));
                            S[r] = __builtin_amdgcn_exp2f(((S[r] - Dp[r]) - Bst) - slope2 * fabsf(t)); }
                    } else {
                        const float e0 = slope2 * (base + (float)(32 * sub));
                        const float E = (kv0 < kvmix ? e0 : -e0) - Bst;
                        const f32x2 E2 = {E, E};
#pragma unroll
                        for (int r = 0; r < 16; r += 2) { const f32x2 t2 = (f32x2){S[r], S[r + 1]} + E2;
                            S[r] = __builtin_amdgcn_exp2f(t2.x); S[r + 1] = __builtin_amdgcn_exp2f(t2.y); }
                    }
#pragma unroll
                    for (int r = 0; r < 16; r += 2) rs2 += (f32x2){S[r], S[r + 1]};
                    bf16x8 pb[2];
#pragma unroll
                    for (int sl = 0; sl < 2; ++sl)
                        pb[sl] = pack8(S[8 * sl + 0], S[8 * sl + 1], S[8 * sl + 2], S[8 * sl + 3], S[8 * sl + 4], S[8 * sl + 5], S[8 * sl + 6], S[8 * sl + 7]);
#pragma unroll
                    for (int d = 0; d < 4; ++d)
#pragma unroll
                        for (int sl = 0; sl < 2; ++sl) { const bf16x8 va = *(const LAS bf16x8*)(st + d * 4096 + (vb_ ^ (32 * (2 * sub + sl))));
                            O[d] = __builtin_amdgcn_mfma_f32_32x32x16_bf16(va, pb[sl], O[d], 0, 0, 0); }
                }
                l += rs2.x + rs2.y;
                if (mixed) {
                    asm volatile("" ::: "memory");
#pragma unroll
                    for (int r = 0; r < 16; ++r) Dp[r] = -Dp[r];
                }
            }
            l += __shfl_xor(l, 32);
            const float inv = 1.0f / l;
            float* pp = park + lane * 4; asm volatile("" : "+v"(pp));
            if (c == 0) {
#pragma unroll
                for (int d = 0; d < 4; ++d)
#pragma unroll
                    for (int q4 = 0; q4 < 4; ++q4) *(f32x4*)(pp + (d * 4 + q4) * 256) = (f32x4){O[d][4 * q4 + 0] * inv, O[d][4 * q4 + 1] * inv, O[d][4 * q4 + 2] * inv, O[d][4 * q4 + 3] * inv};
            } else {
                float ss = 0.f;
#pragma unroll
                for (int d = 0; d < 4; ++d)
#pragma unroll
                    for (int q4 = 0; q4 < 4; ++q4) { const f32x4 pk = *(const f32x4*)(pp + (d * 4 + q4) * 256);
#pragma unroll
                        for (int e = 0; e < 4; ++e) { const float v = pk[e] - lam * (O[d][4 * q4 + e] * inv); O[d][4 * q4 + e] = v; ss += v * v; } }
                ss += __shfl_xor(ss, 32);
                const float rstd = rsqrtf(ss * (1.0f / 128.0f) + EPS) * 0.8f;
                bf16_t* yp = Y + (size_t)(tokb + q0w + r32) * 1024 + 512 + h * 128 + 4 * hi;
#pragma unroll
                for (int d = 0; d < 4; ++d)
#pragma unroll
                    for (int gq4 = 0; gq4 < 4; ++gq4) { const int dcol = 32 * d + 8 * gq4 + 4 * hi; const f32x4 sg = *(const f32x4*)(subg + dcol);
                        u32x2 w; w.x = pk2(O[d][4 * gq4 + 0] * rstd * sg[0], O[d][4 * gq4 + 1] * rstd * sg[1]); w.y = pk2(O[d][4 * gq4 + 2] * rstd * sg[2], O[d][4 * gq4 + 3] * rstd * sg[3]);
                        *(u32x2*)(yp + 32 * d + 8 * gq4) = w; }
            }
        }
        asm volatile("s_waitcnt lgkmcnt(0)" ::: "memory");
        __builtin_amdgcn_s_barrier();
#undef DF_ISSUE
    }
}


constexpr int NA_STAGE = 16384, NA_NST = 4, NA_TAB = 65536;
__device__ __forceinline__ void na_block(LAS unsigned char* lds, const bf16_t* QK, const bf16_t* VT, const float* rpb, const float* gtab, bf16_t* Y, int G, int vcu, int wave, int lane) {
    const int fr = lane & 15, fq = lane >> 4, tid = wave * 64 + lane;
    float Bqk;
    { float gq = fabsf(gtab[lane]), gk = fabsf(gtab[64 + lane]);
#pragma unroll
      for (int o = 1; o < 64; o <<= 1) { gq = fmaxf(gq, __shfl_xor(gq, o)); gk = fmaxf(gk, __shfl_xor(gk, o)); }
      Bqk = 11.6f * gq * gk + 0.5f; }
    LAS float* tab = (LAS float*)(lds + NA_TAB);
    const int prow = 8 * wave + (lane >> 3), pch = ((lane & 7) ^ ((prow >> 1) & 7)) * 8;
    const size_t ksrc = (size_t)prow * 2048 + pch, vsrc = (size_t)prow * M_TOK + pch;
    int koff[4][2], voff[4], w0s[4];
#pragma unroll
    for (int tk = 0; tk < 4; ++tk) { const int w0 = (tk == 0) ? 0 : (tk == 1) ? 8 : (tk == 2) ? 24 : 32; w0s[tk] = w0;
#pragma unroll
        for (int t = 0; t < 2; ++t) { const int kc = w0 + 8 * (fr >> 2) + 4 * t + (fr & 3); koff[tk][t] = kc * 128 + ((fq ^ ((kc >> 1) & 7)) * 16); }
        voff[tk] = 8192 + fr * 128 + ((((w0 >> 3) + fq) ^ ((fr >> 1) & 7)) * 16); }
    int hcur = -1; float Bst = 0.f;
    int tbase[4];
#pragma unroll
    for (int tk = 0; tk < 4; ++tk) { const int qc = 16 * tk + fr; const int v = qc < 8 ? 1 + qc : (qc > 56 ? qc - 48 : 0);
        tbase[tk] = NA_TAB + v * 3840 + (w0s[tk] + 8 * fq - qc + 31) * 4; }
    for (int u = vcu; u < NBATCH * 8 * 4 * ((DUP_MASK & 256) ? 2 : 1); u += G) {
        const int band = u & 3, h = (u >> 2) & 7, b = (u >> 5) & 31;
        if (h != hcur) {
            hcur = h;
    { float mxb = 0.f;
      for (int i = lane; i < 15 * 31; i += 64) mxb = fmaxf(mxb, fabsf(rpb[h * 465 + i]));
#pragma unroll
      for (int o = 1; o < 64; o <<= 1) mxb = fmaxf(mxb, __shfl_xor(mxb, o));
      Bst = Bqk + LOG2E * mxb; }
    for (int i = tid; i < 16 * 15 * 64; i += 512) { const int v = i / 960, rem = i - v * 960, dr = rem >> 6, dc = (rem & 63) - 16;
        const int qcv = (v == 0) ? 32 : (v <= 8 ? v - 1 : 48 + v); int cs = qcv - 8; cs = cs < 0 ? 0 : (cs > 48 ? 48 : cs);
        const int dlo = cs - qcv + 15; const bool ok = (dc >= dlo) && (dc < dlo + 16);
        int dcc = dc < 0 ? 0 : (dc > 30 ? 30 : dc);
        const float val = rpb[(h * 15 + dr) * 31 + dcc] * LOG2E - Bst;
        tab[i] = ok ? val : -1e30f; }
            asm volatile("s_waitcnt lgkmcnt(0)" ::: "memory"); __builtin_amdgcn_s_barrier();
        }
        const int R0 = 8 * band, r = R0 + wave, tokb = b * SEQ;
        int r0 = r - 4; r0 = r0 < 0 ? 0 : (r0 > 24 ? 24 : r0);
        int klo = R0 - 4; klo = klo < 0 ? 0 : klo;
        int khi = R0 + 3; khi = (khi > 24 ? 24 : khi) + 7;
        const int nsteps = khi - klo + 1;
        const bf16_t* Kg = QK + (size_t)(tokb + klo * 64) * 2048 + 512 + h * 64;
        const bf16_t* Vg = VT + (size_t)(h * 64) * M_TOK + tokb + klo * 64;
        bf16x8 qf[4][2];
#pragma unroll
        for (int tk = 0; tk < 4; ++tk)
#pragma unroll
            for (int ks = 0; ks < 2; ++ks) qf[tk][ks] = ld16(QK + (size_t)(tokb + r * 64 + 16 * tk + fr) * 2048 + h * 64 + 32 * ks + 8 * fq);
#define NA_ISSUE(s_) do { LAS unsigned char* sb_ = lds + ((s_) & 3) * NA_STAGE + wave * 1024; \
            __builtin_amdgcn_global_load_lds((const unsigned*)(Kg + (size_t)(s_) * 64 * 2048 + ksrc), (LAS unsigned*)(sb_), 16, 0, 0); \
            __builtin_amdgcn_global_load_lds((const unsigned*)(Vg + (s_) * 64 + vsrc), (LAS unsigned*)(sb_ + 8192), 16, 0, 0); } while (0)
        NA_ISSUE(0); NA_ISSUE(1); NA_ISSUE(2);
        f32x4 O[4][4]; float l[4];
#pragma unroll
        for (int tk = 0; tk < 4; ++tk) { l[tk] = 0.f;
#pragma unroll
            for (int dt = 0; dt < 4; ++dt) O[tk][dt] = (f32x4){0.f, 0.f, 0.f, 0.f}; }
#pragma unroll 1
        for (int s_ = 0; s_ < nsteps; ++s_) {
            if (s_ + 2 < nsteps) { asm volatile("s_waitcnt vmcnt(4)" ::: "memory"); } else if (s_ + 1 < nsteps) { asm volatile("s_waitcnt vmcnt(2)" ::: "memory"); } else { asm volatile("s_waitcnt vmcnt(0)" ::: "memory"); }
            asm volatile("s_waitcnt lgkmcnt(0)" ::: "memory");
            __builtin_amdgcn_s_barrier();
            asm volatile("" ::: "memory");
            if (s_ + 3 < nsteps) NA_ISSUE(s_ + 3);
            const int kr = klo + s_;
            if (kr >= r0 && kr < r0 + 8) {
                LAS unsigned char* st = lds + (s_ & 3) * NA_STAGE;
                const int droff = (kr - r + 7) * 256;
#pragma unroll
                for (int tk = 0; tk < 4; ++tk) {
                    f32x4 sv[2]; const int tb = tbase[tk] + droff;
#pragma unroll
                    for (int t = 0; t < 2; ++t) {
                        const bf16x8 a0 = *(const LAS bf16x8*)(st + koff[tk][t]), a1 = *(const LAS bf16x8*)(st + (koff[tk][t] ^ 64));
                        f32x4 acc = {0.f, 0.f, 0.f, 0.f};
                        acc = __builtin_amdgcn_mfma_f32_16x16x32_bf16(a0, qf[tk][0], acc, 0, 0, 0);
                        acc = __builtin_amdgcn_mfma_f32_16x16x32_bf16(a1, qf[tk][1], acc, 0, 0, 0);
                        sv[t] = acc;
                    }
                    float ps = 0.f;
#pragma unroll
                    for (int t = 0; t < 2; ++t)
#pragma unroll
                        for (int j = 0; j < 4; ++j) { const float bb = *(const LAS float*)(lds + tb + (4 * t + j) * 4);
                            const float p = __builtin_amdgcn_exp2f(sv[t][j] + bb); sv[t][j] = p; ps += p; }
                    l[tk] += ps;
                    const bf16x8 pb = pack8(sv[0][0], sv[0][1], sv[0][2], sv[0][3], sv[1][0], sv[1][1], sv[1][2], sv[1][3]);
#pragma unroll
                    for (int dt = 0; dt < 4; ++dt) { const bf16x8 va = *(const LAS bf16x8*)(st + voff[tk] + dt * 2048);
                        O[tk][dt] = __builtin_amdgcn_mfma_f32_16x16x32_bf16(va, pb, O[tk][dt], 0, 0, 0); }
                    if (tk == 1) __builtin_amdgcn_sched_barrier(0);
                }
            }
        }
#pragma unroll
        for (int tk = 0; tk < 4; ++tk) {
            float lt = l[tk]; lt += __shfl_xor(lt, 16); lt += __shfl_xor(lt, 32);
            const float inv = 1.0f / lt;
            bf16_t* yp = Y + (size_t)(tokb + r * 64 + 16 * tk + fr) * 1024 + h * 64 + 4 * fq;
#pragma unroll
            for (int dt = 0; dt < 4; ++dt) { u32x2 w; w.x = pk2(O[tk][dt][0] * inv, O[tk][dt][1] * inv); w.y = pk2(O[tk][dt][2] * inv, O[tk][dt][3] * inv); *(u32x2*)(yp + 16 * dt) = w; }
        }
        asm volatile("s_waitcnt vmcnt(0) lgkmcnt(0)" ::: "memory");
        __builtin_amdgcn_s_barrier();
#undef NA_ISSUE
    }
}

#define XB_TMO      128
#define XB_XCNT(j)  (256  + 64 * (j))
#define XB_XSUB(j)  (1280 + 64 * (j))
#define XB_XGEN(j)  (2304 + 64 * (j))
#define XB_TOP      3328
#define XB_TOPGEN   3392
#define XCD_BAR_WORDS 3456
#define XB_SPIN_CAP (1u << 22)
__device__ __forceinline__ unsigned xb_ld(unsigned* p)              { return __hip_atomic_load(p, __ATOMIC_RELAXED, __HIP_MEMORY_SCOPE_AGENT); }
__device__ __forceinline__ unsigned xb_add(unsigned* p, unsigned v) { return __hip_atomic_fetch_add(p, v, __ATOMIC_RELAXED, __HIP_MEMORY_SCOPE_AGENT); }
__device__ __forceinline__ unsigned xb_xcc_id() { return (unsigned)__builtin_amdgcn_s_getreg((3 << 11) | 20) & 0xFu; }
#define XB_SPIN(cond, bar) do { unsigned _sp = 0; while (cond) { __builtin_amdgcn_s_sleep(1); \
    if ((++_sp & 255u) == 0u) { if (xb_ld(&(bar)[XB_TMO])) break; if (_sp > XB_SPIN_CAP) { atomicAdd(&(bar)[XB_TMO], 1u); break; } } } } while (0)
struct XcdBarrier { unsigned* bar; unsigned x; volatile LAS unsigned* st; };
__device__ __forceinline__ XcdBarrier xcd_barrier_post(unsigned* bar, volatile LAS unsigned* st) {
    XcdBarrier b; b.bar = bar; b.x = xb_xcc_id(); b.st = st;
    if (threadIdx.x == 0) (void)xb_add(&bar[XB_XCNT(b.x)], 1u);
    return b;
}
__device__ __forceinline__ void xcd_barrier_complete(unsigned* bar, unsigned x, unsigned& nloc, unsigned& nx) {
    const unsigned G = gridDim.x * gridDim.y * gridDim.z;
    unsigned sum, cnt, mine, sp = 0u;
    for (;;) {
        sum = 0u; cnt = 0u; mine = 0u;
#pragma unroll
        for (unsigned j = 0; j < 16; ++j) { const unsigned c = xb_ld(&bar[XB_XCNT(j)]); sum += c; cnt += (c > 0u) ? 1u : 0u; mine = (j == x) ? c : mine; }
        if (sum == G) break;
        __builtin_amdgcn_s_sleep(1);
        if ((++sp & 255u) == 0u) { if (xb_ld(&bar[XB_TMO])) break; if (sp > XB_SPIN_CAP) { atomicAdd(&bar[XB_TMO], 1u); break; } }
    }
    nloc = mine > 0u ? mine : 1u; nx = cnt > 0u ? cnt : 1u;
}
__device__ __forceinline__ void xcd_barrier(const XcdBarrier& b) {
    asm volatile("s_waitcnt vmcnt(0)" ::: "memory");
    __syncthreads();
    if (threadIdx.x == 0) {
        unsigned* bar = b.bar;
        __builtin_amdgcn_s_waitcnt(0);
        unsigned nloc = b.st[0], nx = b.st[1];
        if (nloc == 0u) { xcd_barrier_complete(bar, b.x, nloc, nx); b.st[0] = nloc; b.st[1] = nx; }
        const unsigned old = xb_add(&bar[XB_XSUB(b.x)], 1u);
        const unsigned gen = old / nloc;
        if (old + 1u == (gen + 1u) * nloc) {
            __builtin_amdgcn_fence(__ATOMIC_RELEASE, "agent");
            asm volatile("s_waitcnt vmcnt(0)" ::: "memory");
            const unsigned og = xb_add(&bar[XB_TOP], 1u);
            const unsigned tg = og / nx;
            if (og + 1u == (tg + 1u) * nx) xb_add(&bar[XB_TOPGEN], 1u);
            else XB_SPIN(xb_ld(&bar[XB_TOPGEN]) == tg, bar);
            __builtin_amdgcn_fence(__ATOMIC_ACQUIRE, "agent");
            xb_add(&bar[XB_XGEN(b.x)], 1u);
            asm volatile("s_waitcnt vmcnt(0)" ::: "memory");
        } else {
            XB_SPIN(xb_ld(&bar[XB_XGEN(b.x)]) == gen, bar);
            __builtin_amdgcn_fence(__ATOMIC_ACQUIRE, "agent");
            asm volatile("s_waitcnt vmcnt(0)" ::: "memory");
        }
    }
    __syncthreads();
}

typedef const Args* KArgs;
__device__ __forceinline__ KArgs kargs() { unsigned long long p = (unsigned long long)__builtin_amdgcn_kernarg_segment_ptr(); asm volatile("" : "+s"(p)); return (KArgs)(const __attribute__((address_space(4))) Args*)p; }
__global__ void __launch_bounds__(NWAVES * 64, 2) mega_fwd(Args a_unused) {
    extern __shared__ __attribute__((aligned(16))) unsigned char lds_raw[];
    cg::grid_group grid = cg::this_grid();
    LAS unsigned char* lds = (LAS unsigned char*)lds_raw;
    const int wave = __builtin_amdgcn_readfirstlane((int)threadIdx.x >> 6);
#define FRESH_LANE() ({ int t_ = threadIdx.x; asm volatile("" : "+v"(t_)); t_ & 63; })
    const int G = gridDim.x, bx = blockIdx.x;
    const int vcu = (G % 8 == 0) ? (bx % 8) * (G / 8) + bx / 8 : bx;
    const int gw = vcu * NWAVES + wave, NGW = G * NWAVES;
#define WSP(T, off) ((T*)(kargs()->ws + (off)))
#define MOD WSP(float, WS_MOD)
#define GTAB WSP(float, WS_MOD + 800 * 1024)
#define W1A WSP(bf16_t, WS_W1A)
#define WV WSP(bf16_t, WS_WV)
#define WBR WSP(bf16_t, WS_WBR)
#define WOUT WSP(bf16_t, WS_WOUT)
#define WUP WSP(bf16_t, WS_WUP)
#define WDN WSP(bf16_t, WS_WDN)
#define H WSP(bf16_t, WS_H)
#define QK WSP(bf16_t, WS_QK)
#define GATES WSP(bf16_t, WS_GATES)
#define VT WSP(bf16_t, WS_VT)
#define Y WSP(bf16_t, WS_Y)
#define MIX WSP(bf16_t, WS_MIX)
#define ACT WSP(bf16_t, WS_ACT)
#define H8 WSP(unsigned char, WS_H8)
#define WG8 WSP(unsigned char, WS_WG8)
    LAS float* scr = (LAS float*)(lds + wave * 16384);
    volatile LAS unsigned* bst = (volatile LAS unsigned*)(lds + 131072 + 64);
    if (threadIdx.x < 2) bst[threadIdx.x] = 0u;
    __syncthreads();
    (void)xcd_barrier_post(WSP(unsigned, WS_BAR), bst);
#define GRID_BAR() do { XcdBarrier b_; b_.bar = (unsigned*)(kargs()->ws + WS_BAR); b_.x = xb_xcc_id(); b_.st = (volatile LAS unsigned*)((LAS unsigned char*)lds_raw + 131072 + 64); xcd_barrier(b_); } while (0)

    if (PH_MASK & 1) {
        const int lane = FRESH_LANE();
        constexpr int I1 = 2048, I2 = 512, I3 = 512, I4 = 512, I5 = 2816, I6 = 1408, IMOD = 1536, NIT = I1 + I2 + I3 + I4 + I5 + I6 + IMOD;
        const Args a = *kargs();
        float* const MODl = MOD; float* const GTABl = GTAB; bf16_t* const W1Al = W1A; bf16_t* const WVl = WV; bf16_t* const WBRl = WBR; bf16_t* const WOUTl = WOUT; bf16_t* const WUPl = WUP; bf16_t* const WDNl = WDN; unsigned char* const WG8l = WG8;
        if (gw == 0) { GTABl[lane] = a.na_q_g[lane]; GTABl[64 + lane] = a.na_k_g[lane]; GTABl[128 + lane] = a.df_q_g[lane]; GTABl[192 + lane] = a.df_k_g[lane]; }
        for (int rep_ = 0; rep_ < ((DUP_MASK & 1) ? 2 : 1); ++rep_)
        for (int it = gw; it < NIT; it += NGW) {
            int r = it;
            if (r < IMOD) { if (rep_ == 0) mod_item(a, MODl, r % 96, r / 96, scr, lane); continue; } r -= IMOD;
            if (r < I1) { const int kb = r >> 7, db = r & 127, pn = db >> 3, q = db & 7, lc = 64 * (q & 3) + 32 * (q >> 2);
                if (pn < 8) transpose_item(a.w_in, 3072, kb * 64, (pn < 4 ? pn : pn + 2) * 256 + lc, W1Al, 1024, db * 32, scr, lane);
                else transpose_item_fp8(a.w_gate, 2048, kb * 64, (pn - 8) * 256 + lc, WG8l, 1024, (db - 64) * 32, 32.0f, scr, lane);
                continue; } r -= I1;
            if (r < I2) { const int kb = r >> 5, db = r & 31, f0 = db * 32; transpose_item(a.w_in, 3072, kb * 64, f0 < 512 ? 1024 + f0 : 2048 + f0, WVl, 1024, f0, scr, lane); continue; } r -= I2;
            if (r < I3) { const int br = r >> 8, rr = r & 255, kb = rr >> 5, db = rr & 31; transpose_item(br ? a.w_df_proj : a.w_na_proj, 1024, kb * 64, db * 32, WBRl + (size_t)br * 1024 * 512, 512, db * 32, scr, lane); continue; } r -= I3;
            if (r < I4) { const int kb = r >> 5, db = r & 31; transpose_item(a.w_out, 1024, kb * 64, db * 32, WOUTl, 1024, db * 32, scr, lane); continue; } r -= I4;
            if (r < I5) { const int kb = r / 176, db = r % 176, pn = db >> 3, q = db & 7; transpose_item(a.w_up, NUP, kb * 64, q < 4 ? pn * 128 + q * 32 : DFF + pn * 128 + (q - 4) * 32, WUPl, 1024, db * 32, scr, lane); continue; } r -= I5;
            { const int kb = r >> 5, db = r & 31; transpose_item(a.w_down, 1024, kb * 64, db * 32, WDNl, DFF, db * 32, scr, lane); }
        }
    }
    if (kargs()->ws == nullptr) grid.sync();
    GRID_BAR();
    if (DUP_MASK & 512) { for (int i_ = 0; i_ < 8; ++i_) { GRID_BAR(); } }
    for (int rep_ = 0; rep_ < ((DUP_MASK & 2) ? 2 : 1); ++rep_)
    if (PH_MASK & 2) norm_rows<true>(kargs()->x, kargs()->norm1_g, MOD, 0, 1024, H, gw, NGW, FRESH_LANE(), 0, M_TOK, H8);
    GRID_BAR();
    for (int rep_ = 0; rep_ < ((DUP_MASK & 4) ? 2 : 1); ++rep_) {
    if (DUP_MASK & 2048) {
        pg8::Sched S{256, 8, 256 * 8, G, bx, 1, (const char*)H, (const char*)W1A, (unsigned)(256 * 1024 * 2), (unsigned)(256 * 1024 * 2), 0, 0};
        pg8::EpiG1a E{QK, GATES, GTAB, kargs()->b_gate};
        pg8::gemm_phase<pg8::EpiG1a, false>(lds, 256, 1024, 1024, S, E);
    }
    if (PH_MASK & 4) {
        pg8::Sched S{256, 8, 256 * 8, G, bx, 1, (const char*)H8, (const char*)WG8, 256u * 1024u, 256u * 1024u, 0, 0};
        pg8::EpiGate E{GATES, kargs()->b_gate};
        pg8::gemm_phase<pg8::EpiGate, false, true>(lds, 512, 512, 512, S, E);
    }
    if (PH_MASK & 4) {
        pg8::Sched2 S{256, 8, 256 * 8, 4, 256, 4 * 256, G, bx, (const char*)H, (const char*)W1A, (const char*)WV, (const char*)H, (unsigned)(256 * 1024 * 2), (unsigned)(256 * 1024 * 2)};
        pg8::EpiQKV E{pg8::EpiG1a{QK, GATES, GTAB, kargs()->b_gate}, pg8::EpiPlain{VT, (size_t)M_TOK}};
        pg8::gemm_phase<pg8::EpiQKV, false, false, pg8::Sched2>(lds, 1024, 1024, 1024, S, E);
    }
    }
    GRID_BAR();
    if (PH_MASK & 8) {
        const int lane = FRESH_LANE();
        KArgs ka = kargs(); const float* lq1 = ka->lam_q1; const float* lk1 = ka->lam_k1; const float* lq2 = ka->lam_q2; const float* lk2 = ka->lam_k2; const float* subg = ka->df_subln_g;
        float lam;
        { const float p1 = wave_sum(lq1[lane] * lk1[lane]), p2 = wave_sum(lq2[lane] * lk2[lane]); lam = expf(p1) - expf(p2) + 0.2f; }
        df_block(lds, QK, VT, subg, GTAB, Y, WSP(float, WS_PARK), lam, G, vcu, wave, lane);
        na_block(lds, QK, VT, kargs()->na_rpb, GTAB, Y, G, vcu, wave, FRESH_LANE());
    }
    GRID_BAR();
    if (PH_MASK & 16) {
        pg8::Sched S{256, 4, 256 * 4, G, bx, 2, (const char*)Y, (const char*)WBR, (unsigned)(256 * 1024 * 2), (unsigned)(256 * 512 * 2), (size_t)512 * 2, (unsigned)(1024 * 512 * 2)};
        pg8::EpiBranch E{MIX, GATES};
        pg8::gemm_phase<pg8::EpiBranch, false>(lds, 512, 1024, 512, S, E);
    }
    GRID_BAR();
    if (false && G == 256) {
        const int vcu_ = (bx % 8) * (G / 8) + bx / 8;
        if (PH_MASK & 32) {
            pg8::Sched S{256, 4, 256 * 4, G, vcu_, 0, (const char*)MIX, (const char*)WOUT, (unsigned)(256 * 1024 * 2), (unsigned)(256 * 1024 * 2), 0, 0};
            pg8::EpiRes E{kargs()->x, kargs()->out, MOD + 2048};
            pg8::gemm_phase<pg8::EpiRes, false>(lds, 1024, 1024, 1024, S, E);
        }
        asm volatile("s_waitcnt vmcnt(0)" ::: "memory");
        __syncthreads();
        if (PH_MASK & 2) norm_rows(kargs()->out, kargs()->norm2_g, MOD, 3072, 4096, H, wave, NWAVES, FRESH_LANE(), vcu_ * 256, vcu_ * 256 + 256);
    } else {
    if (PH_MASK & 32) {
        pg8::Sched S{256, 4, 256 * 4, G, bx, 1, (const char*)MIX, (const char*)WOUT, (unsigned)(256 * 1024 * 2), (unsigned)(256 * 1024 * 2), 0, 0};
        pg8::EpiRes E{kargs()->x, kargs()->out, MOD + 2048};
        pg8::gemm_phase<pg8::EpiRes, false>(lds, 1024, 1024, 1024, S, E);
    }
    GRID_BAR();
    if (PH_MASK & 2) norm_rows(kargs()->out, kargs()->norm2_g, MOD, 3072, 4096, H, gw, NGW, FRESH_LANE());
    }
    GRID_BAR();
    for (int rep_ = 0; rep_ < ((DUP_MASK & 64) ? 2 : 1); ++rep_)
    if (PH_MASK & 64) {
        pg8::Sched S{265, 22, 265 * 22, G, bx, 1, (const char*)(H - 1024), (const char*)WUP, (unsigned)(248 * 1024 * 2), (unsigned)(256 * 1024 * 2), 0, 0};
        pg8::EpiUp E{ACT, kargs()->conv_w, kargs()->conv_b};
        pg8::gemm_phase<pg8::EpiUp, true>(lds, 1024, 1024, 1024, S, E);
    }
    GRID_BAR();
    if (DUP_MASK & 128) {
        pg8::Sched S{256, 4, 256 * 4, G, bx, 1, (const char*)ACT, (const char*)WDN, (unsigned)(256 * DFF * 2), (unsigned)(256 * DFF * 2), 0, 0};
        float* outp = kargs()->out; pg8::EpiRes E{outp, WSP(float, 641 * MiB), MOD + 5120};
        pg8::gemm_phase<pg8::EpiRes, false>(lds, DFF, DFF, DFF, S, E);
    }
    if (PH_MASK & 128) {
        pg8::Sched S{256, 4, 256 * 4, G, bx, 1, (const char*)ACT, (const char*)WDN, (unsigned)(256 * DFF * 2), (unsigned)(256 * DFF * 2), 0, 0};
        float* outp = kargs()->out; pg8::EpiRes E{outp, outp, MOD + 5120};
        pg8::gemm_phase<pg8::EpiRes, false>(lds, DFF, DFF, DFF, S, E);
    }
}

extern "C" void kernel_launch(void* const* d_in, const int* in_sizes, int n_in, void* d_out, int out_size, void* d_ws, size_t ws_size, hipStream_t stream) {
    static int grid = 0;
    if (grid == 0) {
        if (n_in != 26 || out_size != M_TOK * DM || ws_size < WS_END) { fprintf(stderr, "kernel_launch: unexpected shapes (n_in %d out %d ws %zu)\n", n_in, out_size, ws_size); grid = -1; return; }
        int dev = 0, cus = 0, per_cu = 0;
        hipGetDevice(&dev); hipDeviceGetAttribute(&cus, hipDeviceAttributeMultiprocessorCount, dev);
        hipFuncSetAttribute((const void*)mega_fwd, hipFuncAttributeMaxDynamicSharedMemorySize, LDS_BYTES);
        hipOccupancyMaxActiveBlocksPerMultiprocessor(&per_cu, (const void*)mega_fwd, NWAVES * 64, LDS_BYTES);
        if (per_cu < 1) per_cu = 1;
        grid = cus * 1;
        (void)hipGetLastError();
    }
    if (grid < 0) return;
    hipMemsetAsync((char*)d_ws + WS_MOD, 0, 1 * MiB, stream);
    Args a{};
    const float** ap = (const float**)&a;
    for (int i = 0; i < 26; ++i) ap[i] = (const float*)d_in[i];
    a.out = (float*)d_out; a.ws = (unsigned char*)d_ws;
    void* args[] = {&a};
    hipError_t e = hipLaunchCooperativeKernel((const void*)mega_fwd, dim3(grid), dim3(NWAVES * 64), args, LDS_BYTES, stream);
    if (e != hipSuccess) fprintf(stderr, "cooperative launch failed: %s (grid %d)\n", hipGetErrorString(e), grid);
}
```
